# Optimizing an MI355X kernel written in HIP

```python
import jax, jax.numpy as jnp
from jax import lax
import numpy as np

D_MODEL = 1024
BATCH = 4
SEQ = 4096
DEPTH = 4

N_MIXERS = 2
SB_HEADS = 16
SB_HEAD_DIM = D_MODEL // SB_HEADS
SB_BLOCK = 128
RET_HEADS = 4
RET_QK_DIM = D_MODEL // RET_HEADS
RET_V_DIM = 2 * D_MODEL // RET_HEADS
RET_CHUNK = 128
ROPE_BASE = 10000.0
MLP_HIDDEN = 4 * D_MODEL
RMS_EPS = 1e-6
GN_EPS = 1e-6
N_SB_LAYERS = (DEPTH + N_MIXERS - 1) // N_MIXERS
N_RET_LAYERS = DEPTH // N_MIXERS

kernel_name = "hybrid_stickbreaking_retention_trunk"

F32 = jnp.float32


def rms_norm(x, g):
    xf = x.astype(F32)
    y = xf * lax.rsqrt(jnp.mean(xf * xf, axis=-1, keepdims=True) + RMS_EPS)
    return (y * g.astype(F32)).astype(x.dtype)


def stick_breaking_attention(h, w_in, w_out):
    b, s, _ = h.shape
    q, k, v = jnp.split(h @ w_in, 3, axis=-1)

    def heads(t):
        return t.reshape(b, s, SB_HEADS, SB_HEAD_DIM).transpose(0, 2, 1, 3).astype(F32)

    q, k, v = heads(q), heads(k), heads(v)
    scale = SB_HEAD_DIM ** -0.5
    outs = []
    for blk in range(s // SB_BLOCK):
        start = blk * SB_BLOCK
        end = start + SB_BLOCK
        qb = q[:, :, start:end]
        kp = k[:, :, :end]
        vp = v[:, :, :end]
        z = jnp.einsum('bhqd,bhkd->bhqk', qb, kp) * scale
        t_idx = start + jnp.arange(SB_BLOCK)[:, None]
        s_idx = jnp.arange(end)[None, :]
        mask = s_idx < t_idx
        log_keep = jnp.where(mask, jax.nn.log_sigmoid(-z), 0.0)
        later = lax.cumsum(log_keep, axis=3, reverse=True) - log_keep
        a = jnp.where(mask, jnp.exp(jax.nn.log_sigmoid(z) + later), 0.0)
        outs.append(jnp.einsum('bhqk,bhkd->bhqd', a, vp))
    o = jnp.concatenate(outs, axis=2)
    o = o.transpose(0, 2, 1, 3).reshape(b, s, D_MODEL).astype(h.dtype)
    return o @ w_out


def rotary(x, pos):
    half = x.shape[-1] // 2
    inv_freq = 1.0 / (ROPE_BASE ** jnp.linspace(0.0, 1.0, half, dtype=F32))
    ang = pos.astype(F32)[:, None] * inv_freq[None, :]
    cos, sin = jnp.cos(ang), jnp.sin(ang)
    x1, x2 = x[..., :half], x[..., half:]
    return jnp.concatenate([x1 * cos - x2 * sin, x1 * sin + x2 * cos], axis=-1)


def retention(h, w_in, w_out):
    b, s, _ = h.shape
    c = RET_CHUNK
    nc = s // c
    q, k, v, g = jnp.split(h @ w_in, [D_MODEL, 2 * D_MODEL, 4 * D_MODEL], axis=-1)
    q = q.reshape(b, s, RET_HEADS, RET_QK_DIM).transpose(0, 2, 1, 3).astype(F32)
    k = k.reshape(b, s, RET_HEADS, RET_QK_DIM).transpose(0, 2, 1, 3).astype(F32)
    v = v.reshape(b, s, RET_HEADS, RET_V_DIM).transpose(0, 2, 1, 3).astype(F32)
    pos = jnp.arange(s)
    q = rotary(q, pos)
    k = rotary(k, pos) * (RET_QK_DIM ** -0.5)

    log_gamma = jnp.log1p(-jnp.exp2(-5.0 - jnp.arange(RET_HEADS, dtype=F32)))
    idx = jnp.arange(c, dtype=F32)
    rel = idx[:, None] - idx[None, :]
    decay_in = jnp.where(rel >= 0, jnp.exp(log_gamma[:, None, None] * jnp.maximum(rel, 0.0)), 0.0)
    q_decay = jnp.exp(log_gamma[:, None] * (idx + 1.0))[None, :, :, None]
    k_decay = jnp.exp(log_gamma[:, None] * (c - 1.0 - idx))[None, :, :, None]
    chunk_decay = jnp.exp(log_gamma * c)[None, :, None, None]

    qc = q.reshape(b, RET_HEADS, nc, c, RET_QK_DIM)
    kc = k.reshape(b, RET_HEADS, nc, c, RET_QK_DIM)
    vc = v.reshape(b, RET_HEADS, nc, c, RET_V_DIM)

    scores = jnp.einsum('bhnid,bhnjd->bhnij', qc, kc) * decay_in[None, :, None]
    inner = jnp.einsum('bhnij,bhnje->bhnie', scores, vc)

    def step(state, xs):
        q_n, k_n, v_n = xs
        cross = jnp.einsum('bhid,bhde->bhie', q_n, state) * q_decay
        state = state * chunk_decay + jnp.einsum('bhjd,bhje->bhde', k_n * k_decay, v_n)
        return state, cross

    state0 = jnp.zeros((b, RET_HEADS, RET_QK_DIM, RET_V_DIM), F32)
    xs = (qc.transpose(2, 0, 1, 3, 4), kc.transpose(2, 0, 1, 3, 4), vc.transpose(2, 0, 1, 3, 4))
    _, cross = lax.scan(step, state0, xs)
    o = (inner + cross.transpose(1, 2, 0, 3, 4)).reshape(b, RET_HEADS, s, RET_V_DIM)

    mu = jnp.mean(o, axis=-1, keepdims=True)
    var = jnp.mean(jnp.square(o - mu), axis=-1, keepdims=True)
    o = (o - mu) * lax.rsqrt(var + GN_EPS)
    o = o.transpose(0, 2, 1, 3).reshape(b, s, RET_HEADS * RET_V_DIM)
    y = jax.nn.silu(g.astype(F32)) * o
    return y.astype(h.dtype) @ w_out


def squared_relu_mlp(h, w_up, w_down):
    u = jax.nn.relu(h @ w_up)
    return (u * u) @ w_down


def setup_inputs(seed: int = 0) -> dict:
    key = jax.random.key(seed)
    ks = jax.random.split(key, 11)

    def w(k, shape, fan_in):
        return jax.random.normal(k, shape, F32) * (fan_in ** -0.5)

    def gain(k, shape):
        return 1.0 + 0.05 * jax.random.normal(k, shape, F32)

    return {
        "x": jax.random.normal(ks[0], (BATCH, SEQ, D_MODEL), F32),
        "w_sb_in": w(ks[1], (N_SB_LAYERS, D_MODEL, 3 * D_MODEL), D_MODEL),
        "w_sb_out": w(ks[2], (N_SB_LAYERS, D_MODEL, D_MODEL), D_MODEL),
        "w_ret_in": w(ks[3], (N_RET_LAYERS, D_MODEL, 6 * D_MODEL), D_MODEL),
        "w_ret_out": w(ks[4], (N_RET_LAYERS, 2 * D_MODEL, D_MODEL), 2 * D_MODEL),
        "g_mix": gain(ks[5], (DEPTH, D_MODEL)),
        "g_mlp": gain(ks[6], (DEPTH, D_MODEL)),
        "w_mlp_up": w(ks[7], (DEPTH, D_MODEL, MLP_HIDDEN), D_MODEL),
        "w_mlp_down": w(ks[8], (DEPTH, MLP_HIDDEN, D_MODEL), MLP_HIDDEN),
        "g_final": gain(ks[9], (D_MODEL,)),
    }


def reference(x, w_sb_in, w_sb_out, w_ret_in, w_ret_out, g_mix, g_mlp, w_mlp_up, w_mlp_down, g_final):
    h = x
    for layer in range(DEPTH):
        hn = rms_norm(h, g_mix[layer])
        i = layer // N_MIXERS
        if layer % N_MIXERS == 0:
            h = h + stick_breaking_attention(hn, w_sb_in[i], w_sb_out[i])
        else:
            h = h + retention(hn, w_ret_in[i], w_ret_out[i])
        h = h + squared_relu_mlp(rms_norm(h, g_mlp[layer]), w_mlp_up[layer], w_mlp_down[layer])
    return rms_norm(h, g_final)
```

```cpp
#include <hip/hip_runtime.h>
#include <cstdio>
#include <cstdint>

#define PG8_LAS __attribute__((address_space(3)))
#define GAS __attribute__((address_space(1)))
#define LAS __attribute__((address_space(3)))
typedef unsigned short bf16_t;
typedef short bf16x8 __attribute__((ext_vector_type(8)));
typedef float f32x4 __attribute__((ext_vector_type(4)));
typedef float f32x2 __attribute__((ext_vector_type(2)));
typedef unsigned u32x4 __attribute__((ext_vector_type(4)));
typedef unsigned u32x2 __attribute__((ext_vector_type(2)));

constexpr int BATCH = 4, SEQ = 4096, D = 1024, FF = 4096, NLAYER = 4;
constexpr int M = BATCH * SEQ;
constexpr int SBH = 16, SBD = 64;
constexpr int RH = 4, RDK = 256, RDV = 512, RC = 256, RNC = SEQ / RC;
constexpr int NPROB = BATCH * RH * RNC;
constexpr float RMS_EPS = 1e-6f, GN_EPS = 1e-6f;
constexpr float C2 = 0.18033688011112042f;
constexpr float L2B127 = 0.10462765653188542f;
constexpr float INV2PI = 0.15915494309189535f;
constexpr float LOG2E = 1.4426950408889634f;
__device__ __forceinline__ float lg2gamma(int h) { return h == 0 ? -0.04580368961312479f : (h == 1 ? -0.02272007650008353f : (h == 2 ? -0.011315313227834146f : -0.005646563141142063f)); }

constexpr size_t MiB = 1u << 20;
constexpr size_t WS_CTL = 0, CTL_ZERO_BYTES = 1 * MiB;
constexpr size_t WS_SSQ = 1 * MiB;
constexpr size_t WS_GN = 2 * MiB;
constexpr size_t WS_HBF = 6 * MiB;
constexpr size_t WS_WMIX = 38 * MiB;
constexpr size_t WS_SCR = 54 * MiB;
constexpr size_t WS_Q = WS_SCR, WS_K = WS_SCR + 32 * MiB, WS_V = WS_SCR + 64 * MiB;
constexpr size_t WS_SQ = WS_SCR;
constexpr size_t WS_VS = WS_SCR + 64 * MiB;
constexpr size_t WS_KN = WS_SCR + 192 * MiB;
constexpr size_t WS_Y = WS_VS;
constexpr size_t WS_U = WS_SCR;
constexpr size_t WS_WMLP = WS_SCR + 192 * MiB;
constexpr size_t WS_END = WS_SCR + 224 * MiB;
constexpr size_t SQ_P = 256 * 512, VS_P = 512 * 512;

constexpr int RING_BYTES = 131072, LDSCTL_OFF = RING_BYTES, MISC_OFF = LDSCTL_OFF + 320, LDS_BYTES = 147456;
constexpr int NWAVES = 8;

__device__ __forceinline__ unsigned cvt_pk_bf16(float lo, float hi) { unsigned r; asm volatile("v_cvt_pk_bf16_f32 %0, %1, %2" : "=v"(r) : "v"(lo), "v"(hi)); return r; }
__device__ __forceinline__ float bf_lo(unsigned w) { return __uint_as_float(w << 16); }
__device__ __forceinline__ float bf_hi(unsigned w) { return __uint_as_float(w & 0xffff0000u); }
__device__ __forceinline__ u32x4 pack8(f32x4 a, f32x4 b) { u32x4 w; w.x = cvt_pk_bf16(a[0], a[1]); w.y = cvt_pk_bf16(a[2], a[3]); w.z = cvt_pk_bf16(b[0], b[1]); w.w = cvt_pk_bf16(b[2], b[3]); return w; }
__device__ __forceinline__ float wave_sum(float v) {
#pragma unroll
    for (int o = 1; o < 64; o <<= 1) v += __shfl_xor(v, o);
    return v;
}
__device__ __forceinline__ float rinv_of(float ss) { return 1.0f / sqrtf(ss * (1.0f / D) + RMS_EPS); }
#define LDS_WAIT() asm volatile("s_waitcnt lgkmcnt(0)" ::: "memory")
#define VM_WAIT() asm volatile("s_waitcnt vmcnt(0)" ::: "memory")

namespace pg8 {
constexpr int BM = 256, BK = 64, HALF = 128, HTB = HALF * BK * 2, STAGE_BYTES = 8 * HTB, NXCD = 8, WGM = 8;
__host__ __device__ __forceinline__ int lds_byte(int r, int c) { const int st = (r >> 4) * 2 + (c >> 5), rr = r & 15, cc = c & 31, ob = rr * 64 + cc * 2; return st * 1024 + (ob ^ (((ob >> 9) & 1) << 5)); }
__host__ __device__ __forceinline__ void stage_rc(int b, int& R, int& C) { const int st = b / 1024, sb = b % 1024, swz = sb ^ (((sb >> 9) & 1) << 5); R = (st >> 1) * 16 + swz / 64; C = (st & 1) * 32 + (swz % 64) / 2; }
__host__ __device__ __forceinline__ int perm32(int rho) { const int n = rho >> 4, i = rho & 15; return 8 * (i >> 2) + 4 * n + (i & 3); }

struct Unit { int pm, pn, p; const char* a; const char* b; };

struct StdOrder {
    int nM, nN, nwg, G, c; const char* A; const char* B; size_t tA, tB;
    __device__ __forceinline__ void init(int Mr, int Nc, int G_, int c_, const void* A_, const void* B_, int lda, int ldb) { nM = Mr / BM; nN = Nc / BM; nwg = nM * nN; G = G_; c = c_; A = (const char*)A_; B = (const char*)B_; tA = (size_t)BM * lda * 2; tB = (size_t)BM * ldb * 2; }
    __device__ __forceinline__ bool next(int i, Unit& u) const {
        const long L = (long)i * G + c; if (L >= nwg) return false;
        int wgid = (int)L; { const int q = nwg / NXCD, r = nwg % NXCD, xcd = wgid % NXCD, off = wgid / NXCD; wgid = (xcd < r ? xcd * (q + 1) : r * (q + 1) + (xcd - r) * q) + off; }
        const int nig = WGM * nN, gid = wgid / nig, fm = gid * WGM, gsz = (nM - fm) < WGM ? (nM - fm) : WGM;
        u.pm = fm + ((wgid % nig) % gsz); u.pn = (wgid % nig) / gsz; u.p = 0; u.a = A + (size_t)u.pm * tA; u.b = B + (size_t)u.pn * tB; return true;
    }
};

template <class Epi, class Sched, int LDA, int LDB, int KD, bool ALIGN_EPI>
__device__ __forceinline__ void gemm_phase(PG8_LAS unsigned char* lds, const Sched& S, const Epi& E) {
    int tid = threadIdx.x; asm volatile("" : "+v"(tid));
    const int wid = __builtin_amdgcn_readfirstlane(tid >> 6), lane = tid & 63, wr = wid >> 2, wc = wid & 3, fr = lane & 15, fq = lane >> 4;
    constexpr int nt = KD / BK;
    static_assert(KD % 128 == 0 && KD >= 256, "K multiple of 128, >= 256");
    unsigned voffA[2], voffB[2];
#pragma unroll
    for (int i = 0; i < 2; ++i) { int R, C; stage_rc(tid * 16 + i * 8192, R, C); const int Rb = (R & ~31) + perm32(R & 31);
        voffA[i] = (unsigned)(R * LDA + C) * 2u; voffB[i] = (unsigned)(Rb * LDB + C) * 2u; }
    constexpr size_t kstep = (size_t)(BK * 2), hstepA = (size_t)HALF * LDA * 2, hstepB = (size_t)HALF * LDB * 2;
    const unsigned ldsw = (unsigned)wid * 1024u;
    const int aoff = lds_byte(wr * 64 + fr, fq * 8), boff = lds_byte(wc * 32 + fr, fq * 8);
#define PG8_SA(b, h) (((b) * 2 + (h)) * HTB)
#define PG8_SB(b, h) ((4 + (b) * 2 + (h)) * HTB)
#define PG8_STAGE(bufoff, gbase, voff) do { _Pragma("unroll") for (int _i = 0; _i < 2; ++_i) \
        __builtin_amdgcn_global_load_lds((const unsigned*)((const char*)(gbase) + (voff)[_i]), (PG8_LAS unsigned*)(lds + (bufoff) + ldsw + _i * 8192), 16, 0, 0); } while (0)
#define PG8_LDA(dst, b, h) do { _Pragma("unroll") for (int m = 0; m < 4; ++m) _Pragma("unroll") for (int k = 0; k < 2; ++k) dst[m][k] = *(const PG8_LAS bf16x8*)(lds + PG8_SA(b, h) + aoff + m * 2048 + k * 1024); } while (0)
#define PG8_LDB(dst, b, h) do { _Pragma("unroll") for (int n = 0; n < 2; ++n) _Pragma("unroll") for (int k = 0; k < 2; ++k) dst[n][k] = *(const PG8_LAS bf16x8*)(lds + PG8_SB(b, h) + boff + n * 2048 + k * 1024); } while (0)
#define PG8_MMA(ai, bj, At, Bt) do { __builtin_amdgcn_s_setprio(1); _Pragma("unroll") for (int m = 0; m < 4; ++m) _Pragma("unroll") for (int n = 0; n < 2; ++n) _Pragma("unroll") for (int k = 0; k < 2; ++k) \
        acc[ai][bj][m][n] = __builtin_amdgcn_mfma_f32_16x16x32_bf16(Bt[n][k], At[m][k], acc[ai][bj][m][n], 0, 0, 0); __builtin_amdgcn_s_setprio(0); } while (0)
#define PG8_WAIT_V(n) asm volatile("s_waitcnt vmcnt(" #n ")" ::: "memory")
#define PG8_WAIT_L(n) asm volatile("s_waitcnt lgkmcnt(" #n ")" ::: "memory")
#define PG8_BAR __builtin_amdgcn_s_barrier()
#define PG8_SCHED __builtin_amdgcn_sched_barrier(0)
    Unit cur, nxt; int ui = 0;
    if (!S.next(0, cur)) return;
    f32x4 acc[2][2][4][2];
#pragma unroll
    for (int a = 0; a < 2; ++a)
#pragma unroll
        for (int b = 0; b < 2; ++b)
#pragma unroll
            for (int m = 0; m < 4; ++m)
#pragma unroll
                for (int n = 0; n < 2; ++n) acc[a][b][m][n] = (f32x4){0.f, 0.f, 0.f, 0.f};
    bf16x8 At[4][2], B0[2][2], B1[2][2];
    const char* cA = cur.a; const char* cB = cur.b;
    PG8_STAGE(PG8_SB(0, 0), cB, voffB); PG8_STAGE(PG8_SB(0, 1), cB + hstepB, voffB); PG8_STAGE(PG8_SA(0, 0), cA, voffA); PG8_STAGE(PG8_SA(0, 1), cA + hstepA, voffA);
    if (wr == 1) PG8_BAR;
    PG8_WAIT_V(2); PG8_BAR;
    PG8_STAGE(PG8_SB(1, 0), cB + kstep, voffB); PG8_STAGE(PG8_SA(1, 0), cA + kstep, voffA); PG8_STAGE(PG8_SB(1, 1), cB + hstepB + kstep, voffB);
    PG8_WAIT_V(6); PG8_BAR;
    for (;;) {
        const bool has_next = S.next(ui + 1, nxt);
        const char* nA = has_next ? nxt.a : cA; const char* nB = has_next ? nxt.b : cB;
#pragma nounroll
        for (int t = 0; t < nt; t += 2) {
            const bool last = (t == nt - 2);
            const char* a1 = cA + (size_t)(t + 1) * kstep;
            const char* a2 = last ? nA : cA + (size_t)(t + 2) * kstep; const char* b2 = last ? nB : cB + (size_t)(t + 2) * kstep;
            const char* a3 = a2 + kstep; const char* b3 = b2 + kstep;
            PG8_LDB(B0, 0, 0); PG8_LDB(B1, 0, 1); PG8_SCHED; PG8_LDA(At, 0, 0); PG8_STAGE(PG8_SA(1, 1), a1 + hstepA, voffA);
            PG8_WAIT_V(8); PG8_WAIT_L(0); PG8_BAR; PG8_MMA(0, 0, At, B0); PG8_MMA(0, 1, At, B1); PG8_BAR; PG8_SCHED;
            PG8_LDA(At, 0, 1); PG8_STAGE(PG8_SB(0, 0), b2, voffB); PG8_STAGE(PG8_SB(0, 1), b2 + hstepB, voffB); PG8_STAGE(PG8_SA(0, 0), a2, voffA);
            PG8_WAIT_V(8); PG8_WAIT_L(0); PG8_BAR; PG8_MMA(1, 0, At, B0); PG8_MMA(1, 1, At, B1); PG8_BAR; PG8_SCHED;
            PG8_LDB(B0, 1, 0); PG8_LDB(B1, 1, 1); PG8_SCHED; PG8_LDA(At, 1, 0); PG8_STAGE(PG8_SA(0, 1), a2 + hstepA, voffA);
            PG8_WAIT_V(8); PG8_WAIT_L(0); PG8_BAR; PG8_MMA(0, 0, At, B0); PG8_MMA(0, 1, At, B1); PG8_BAR; PG8_SCHED;
            PG8_LDA(At, 1, 1); PG8_STAGE(PG8_SB(1, 0), b3, voffB); PG8_STAGE(PG8_SB(1, 1), b3 + hstepB, voffB); PG8_STAGE(PG8_SA(1, 0), a3, voffA);
            PG8_WAIT_V(8); PG8_WAIT_L(0); PG8_BAR; PG8_MMA(1, 0, At, B0); PG8_MMA(1, 1, At, B1); PG8_BAR; PG8_SCHED;
        }
        if constexpr (ALIGN_EPI) { if (wr == 0) PG8_BAR; }
        E(acc, cur, wr, wc, fr, fq);
        if (!has_next) break;
#pragma unroll
        for (int a = 0; a < 2; ++a)
#pragma unroll
            for (int b = 0; b < 2; ++b)
#pragma unroll
                for (int m = 0; m < 4; ++m)
#pragma unroll
                    for (int n = 0; n < 2; ++n) acc[a][b][m][n] = (f32x4){0.f, 0.f, 0.f, 0.f};
        cur = nxt; cA = nA; cB = nB; ++ui;
        if constexpr (ALIGN_EPI) { if (wr == 1) PG8_BAR; }
    }
    PG8_WAIT_V(0);
    if constexpr (!ALIGN_EPI) { if (wr == 0) PG8_BAR; }
    PG8_BAR;
#undef PG8_SA
#undef PG8_SB
#undef PG8_STAGE
#undef PG8_LDA
#undef PG8_LDB
#undef PG8_MMA
#undef PG8_WAIT_V
#undef PG8_WAIT_L
#undef PG8_BAR
#undef PG8_SCHED
}
typedef f32x4 Acc[2][2][4][2];
}
using pg8::Unit;

__device__ __forceinline__ void rinv_rows(const float* ssq, int rowbase, int fq, float (&ri)[2][4]) {
#pragma unroll
    for (int ai = 0; ai < 2; ++ai)
#pragma unroll
        for (int m = 0; m < 4; ++m) { const f32x4 v = *(const f32x4*)(ssq + (size_t)(rowbase + ai * 128 + m * 16) * 16 + fq * 4);
            float s = (v[0] + v[1]) + (v[2] + v[3]); s += __shfl_xor(s, 16); s += __shfl_xor(s, 32); ri[ai][m] = rinv_of(s); }
}
__device__ __forceinline__ void rinv_cols(const float* ssq, int colbase  , int fr, int lane, float (&rc)[2][8]) {
    const int tok = colbase + 128 * (fr >> 3) + (fr & 7); const f32x4* p = (const f32x4*)(ssq + (size_t)tok * 16);
    const f32x4 a = p[0], b = p[1], c = p[2], d = p[3];
    const float s = (((a[0] + a[1]) + (a[2] + a[3])) + ((b[0] + b[1]) + (b[2] + b[3]))) + (((c[0] + c[1]) + (c[2] + c[3])) + ((d[0] + d[1]) + (d[2] + d[3])));
    const float r = rinv_of(s);
#pragma unroll
    for (int bj = 0; bj < 2; ++bj)
#pragma unroll
        for (int q = 0; q < 8; ++q) rc[bj][q] = __shfl(r, (lane & 48) | (bj * 8 + q));
}
__device__ __forceinline__ void sincos_rev(float ang, float& sn, float& cs) { float rev = ang * INV2PI; rev = __builtin_amdgcn_fractf(rev); sn = __builtin_amdgcn_sinf(rev); cs = __builtin_amdgcn_cosf(rev); }

struct EpiQKV { static constexpr bool PERM = true; bf16_t* q; const float* ssq;
    __device__ __forceinline__ void operator()(const pg8::Acc& acc, const Unit& u, int wr, int wc, int fr, int fq) const {
        asm volatile("" : "+v"(fr), "+v"(fq));
        const int t = u.pn >> 2; bf16_t* base = q + (size_t)t * ((WS_K - WS_Q) / 2); const float sc = t == 0 ? C2 : 1.f;
        const int row0 = u.pm * 256 + wr * 64 + fr, col0 = (u.pn & 3) * 256 + wc * 32 + 8 * fq;
        float ri[2][4]; rinv_rows(ssq, row0, fq, ri);
#pragma unroll
        for (int ai = 0; ai < 2; ++ai)
#pragma unroll
            for (int m = 0; m < 4; ++m) { const float s = ri[ai][m] * sc; bf16_t* rowp = base + (size_t)(row0 + ai * 128 + m * 16) * D + col0;
#pragma unroll
                for (int bj = 0; bj < 2; ++bj) *(u32x4*)(rowp + bj * 128) = pack8(acc[ai][bj][m][0] * s, acc[ai][bj][m][1] * s); }
    }
};
struct EpiRes { static constexpr bool PERM = true; const float* base; float* out; bf16_t* hbf; float* ssq;
    __device__ __forceinline__ void operator()(const pg8::Acc& acc, const Unit& u, int wr, int wc, int fr, int fq) const {
        asm volatile("" : "+v"(fr), "+v"(fq));
        const int row0 = u.pm * 256 + wr * 64 + fr, col0 = u.pn * 256 + wc * 32 + 8 * fq;
#pragma unroll
        for (int ai = 0; ai < 2; ++ai)
#pragma unroll
            for (int m = 0; m < 4; ++m) { const int row = row0 + ai * 128 + m * 16; const size_t off = (size_t)row * D + col0; float ss = 0.f;
#pragma unroll
                for (int bj = 0; bj < 2; ++bj) { const f32x4 h0 = *(const f32x4*)(base + off + bj * 128) + acc[ai][bj][m][0], h1 = *(const f32x4*)(base + off + bj * 128 + 4) + acc[ai][bj][m][1];
                    *(f32x4*)(out + off + bj * 128) = h0; *(f32x4*)(out + off + bj * 128 + 4) = h1; *(u32x4*)(hbf + off + bj * 128) = pack8(h0, h1);
                    ss += ((h0[0] * h0[0] + h0[1] * h0[1]) + (h0[2] * h0[2] + h0[3] * h0[3])) + ((h1[0] * h1[0] + h1[1] * h1[1]) + (h1[2] * h1[2] + h1[3] * h1[3])); }
                ss += __shfl_xor(ss, 16); ss += __shfl_xor(ss, 32); if (fq == 0) ssq[(size_t)row * 16 + u.pn * 4 + wc] = ss;
                asm volatile("" ::: "memory"); }
    }
};
struct EpiUp { static constexpr bool PERM = true; bf16_t* uo; const float* ssq;
    __device__ __forceinline__ void operator()(const pg8::Acc& acc, const Unit& u, int wr, int wc, int fr, int fq) const {
        asm volatile("" : "+v"(fr), "+v"(fq));
        const int row0 = u.pm * 256 + wr * 64 + fr, col0 = u.pn * 256 + wc * 32 + 8 * fq;
        float ri[2][4]; rinv_rows(ssq, row0, fq, ri);
#pragma unroll
        for (int ai = 0; ai < 2; ++ai)
#pragma unroll
            for (int m = 0; m < 4; ++m) { const float s = ri[ai][m]; bf16_t* rowp = uo + (size_t)(row0 + ai * 128 + m * 16) * FF + col0;
#pragma unroll
                for (int bj = 0; bj < 2; ++bj) { f32x4 a = acc[ai][bj][m][0] * s, b = acc[ai][bj][m][1] * s;
#pragma unroll
                    for (int e = 0; e < 4; ++e) { const float x = fmaxf(a[e], 0.f), y = fmaxf(b[e], 0.f); a[e] = x * x; b[e] = y * y; }
                    *(u32x4*)(rowp + bj * 128) = pack8(a, b); } }
    }
};
struct EpiRetQK { static constexpr bool PERM = true; bf16_t* SQ; bf16_t* KN; const float* ssq;
    __device__ __forceinline__ void operator()(const pg8::Acc& acc, const Unit& u, int wr, int wc, int fr, int fq) const {
        asm volatile("" : "+v"(fr), "+v"(fq));
        const bool isq = u.pn < 4; const int h = u.pn & 3, b = u.pm >> 4, N = u.pm & 15, p = (b * 4 + h) * 16 + N;
        const int row0 = u.pm * 256 + wr * 64 + fr, i0 = wr * 64 + fr, cb = wc * 32 + 8 * fq; const float lg = lg2gamma(h);
        float ri[2][4]; rinv_rows(ssq, row0, fq, ri);
        float invf[8];
#pragma unroll
        for (int q = 0; q < 8; ++q) invf[q] = __builtin_amdgcn_exp2f(-(float)(cb + q) * L2B127);
#pragma unroll
        for (int ai = 0; ai < 2; ++ai)
#pragma unroll
            for (int m = 0; m < 4; ++m) { const int il = i0 + ai * 128 + m * 16; const float pos = (float)(N * 256 + il);
                const float s = ri[ai][m], sc = isq ? __builtin_amdgcn_exp2f(lg * (float)(il + 1)) : 0.0625f;
                f32x4 y1[2], y2[2];
#pragma unroll
                for (int n = 0; n < 2; ++n)
#pragma unroll
                    for (int e = 0; e < 4; ++e) { float sn, cs; sincos_rev(pos * invf[n * 4 + e], sn, cs); const float x1 = acc[ai][0][m][n][e] * s, x2 = acc[ai][1][m][n][e] * s;
                        y1[n][e] = (x1 * cs - x2 * sn) * sc; y2[n][e] = (x1 * sn + x2 * cs) * sc; }
                bf16_t* dst = isq ? SQ + (size_t)p * SQ_P + (size_t)il * 512 + 256 + cb : KN + (size_t)(row0 + ai * 128 + m * 16) * 1024 + h * 256 + cb;
                *(u32x4*)dst = pack8(y1[0], y1[1]); *(u32x4*)(dst + 128) = pack8(y2[0], y2[1]); __builtin_amdgcn_sched_barrier(0); }
    }
};
struct EpiRetKVt { static constexpr bool PERM = true; bf16_t* SQ; bf16_t* VS; const float* ssq;
    __device__ __forceinline__ void operator()(const pg8::Acc& acc, const Unit& u, int wr, int wc, int fr, int fq) const {
        asm volatile("" : "+v"(fr), "+v"(fq));
        const int lane = fq * 16 + fr; const int b = u.pn >> 4, N = u.pn & 15, jb = wc * 32 + 8 * fq;
        float rc[2][8]; rinv_cols(ssq, u.pn * 256 + jb, fr, lane, rc);
        if (u.pm < 4) { const int h = u.pm, p = (b * 4 + h) * 16 + N; const float lg = lg2gamma(h);
#pragma unroll
            for (int bj = 0; bj < 2; ++bj)
#pragma unroll
                for (int q = 0; q < 8; ++q) rc[bj][q] *= 0.0625f * __builtin_amdgcn_exp2f(lg * (float)(255 - (bj * 128 + jb + q)));
#pragma unroll
            for (int m = 0; m < 4; ++m) { const int d = wr * 64 + m * 16 + fr; const float invf = __builtin_amdgcn_exp2f(-(float)d * L2B127);
#pragma unroll
                for (int bj = 0; bj < 2; ++bj) { f32x4 y1[2], y2[2];
#pragma unroll
                    for (int n = 0; n < 2; ++n)
#pragma unroll
                        for (int e = 0; e < 4; ++e) { const float pos = (float)(N * 256 + bj * 128 + jb + n * 4 + e); float sn, cs; sincos_rev(pos * invf, sn, cs);
                            const float sc = rc[bj][n * 4 + e], x1 = acc[0][bj][m][n][e] * sc, x2 = acc[1][bj][m][n][e] * sc;
                            y1[n][e] = x1 * cs - x2 * sn; y2[n][e] = x1 * sn + x2 * cs; }
                    bf16_t* dst = SQ + (size_t)p * SQ_P + (size_t)d * 512 + bj * 128 + jb;
                    *(u32x4*)dst = pack8(y1[0], y1[1]); *(u32x4*)(dst + 128 * 512) = pack8(y2[0], y2[1]); __builtin_amdgcn_sched_barrier(0); } }
        } else { const int h = (u.pm - 4) >> 1, eh = (u.pm - 4) & 1, p = (b * 4 + h) * 16 + N;
#pragma unroll
            for (int ai = 0; ai < 2; ++ai)
#pragma unroll
                for (int m = 0; m < 4; ++m) { const int e_row = eh * 256 + ai * 128 + wr * 64 + m * 16 + fr;
#pragma unroll
                    for (int bj = 0; bj < 2; ++bj) { f32x4 a = acc[ai][bj][m][0], c = acc[ai][bj][m][1];
#pragma unroll
                        for (int e = 0; e < 4; ++e) { a[e] *= rc[bj][e]; c[e] *= rc[bj][4 + e]; }
                        *(u32x4*)(VS + (size_t)p * VS_P + (size_t)e_row * 512 + bj * 128 + jb) = pack8(a, c); } }
        }
    }
};
struct EpiKV { static constexpr bool PERM = true; bf16_t* VS;
    __device__ __forceinline__ void operator()(const pg8::Acc& acc, const Unit& u, int wr, int wc, int fr, int fq) const {
        asm volatile("" : "+v"(fr), "+v"(fq));
        bf16_t* base = VS + (size_t)u.p * VS_P + 256 + wc * 32 + 8 * fq;
#pragma unroll
        for (int ai = 0; ai < 2; ++ai)
#pragma unroll
            for (int m = 0; m < 4; ++m) { const int e_row = u.pm * 256 + ai * 128 + wr * 64 + m * 16 + fr;
#pragma unroll
                for (int bj = 0; bj < 2; ++bj) *(u32x4*)(base + (size_t)e_row * 512 + bj * 128) = pack8(acc[ai][bj][m][0], acc[ai][bj][m][1]); }
    }
};
struct EpiS { static constexpr bool PERM = true; bf16_t* SQ;
    __device__ __forceinline__ void operator()(const pg8::Acc& acc, const Unit& u, int wr, int wc, int fr, int fq) const {
        asm volatile("" : "+v"(fr), "+v"(fq));
        const int h = (u.p >> 4) & 3, jb = wc * 32 + 8 * fq; const float lg = lg2gamma(h);
        float gi[2][8];
#pragma unroll
        for (int bj = 0; bj < 2; ++bj)
#pragma unroll
            for (int q = 0; q < 8; ++q) gi[bj][q] = __builtin_amdgcn_exp2f(-lg * (float)(bj * 128 + jb + q + 1));
#pragma unroll
        for (int ai = 0; ai < 2; ++ai)
#pragma unroll
            for (int m = 0; m < 4; ++m) { const int i = ai * 128 + wr * 64 + m * 16 + fr;
#pragma unroll
                for (int bj = 0; bj < 2; ++bj) { f32x4 a = acc[ai][bj][m][0], c = acc[ai][bj][m][1];
#pragma unroll
                    for (int e = 0; e < 4; ++e) { const int d0 = i - (bj * 128 + jb + e);
                        a[e] = __uint_as_float(__float_as_uint(a[e] * gi[bj][e]) & ~(unsigned)(d0 >> 31)); c[e] = __uint_as_float(__float_as_uint(c[e] * gi[bj][4 + e]) & ~(unsigned)((d0 - 4) >> 31)); }
                    *(u32x4*)(SQ + (size_t)u.p * SQ_P + (size_t)i * 512 + bj * 128 + jb) = pack8(a, c); } __builtin_amdgcn_sched_barrier(0); }
    }
};
struct EpiO { static constexpr bool PERM = true; bf16_t* SQ; bf16_t* OH0; float* GN;
    __device__ __forceinline__ void operator()(const pg8::Acc& acc, const Unit& u, int wr, int wc, int fr, int fq) const {
        asm volatile("" : "+v"(fr), "+v"(fq));
        const int bh = u.p >> 4, N = u.p & 15, b = bh >> 2, h = bh & 3, cb = wc * 32 + 8 * fq;
        bf16_t* ob = u.pn == 0 ? OH0 + (size_t)u.p * 65536 : SQ + (size_t)u.p * SQ_P; const int pitch = u.pn == 0 ? 256 : 512;
#pragma unroll
        for (int ai = 0; ai < 2; ++ai)
#pragma unroll
            for (int m = 0; m < 4; ++m) { const int i = ai * 128 + wr * 64 + m * 16 + fr; float s = 0.f, q = 0.f;
#pragma unroll
                for (int bj = 0; bj < 2; ++bj) { const f32x4 a = acc[ai][bj][m][0], c = acc[ai][bj][m][1];
                    s += ((a[0] + a[1]) + (a[2] + a[3])) + ((c[0] + c[1]) + (c[2] + c[3]));
                    q += ((a[0] * a[0] + a[1] * a[1]) + (a[2] * a[2] + a[3] * a[3])) + ((c[0] * c[0] + c[1] * c[1]) + (c[2] * c[2] + c[3] * c[3]));
                    *(u32x4*)(ob + (size_t)i * pitch + bj * 128 + cb) = pack8(a, c); }
                s += __shfl_xor(s, 16); s += __shfl_xor(s, 32); q += __shfl_xor(q, 16); q += __shfl_xor(q, 32);
                if (fq == 0) { const size_t tok = (size_t)b * SEQ + N * 256 + i; *(f32x2*)(GN + (tok * 4 + h) * 16 + (u.pn * 4 + wc) * 2) = (f32x2){s, q}; } }
    }
};
struct EpiG { static constexpr bool PERM = true; const bf16_t* SQ; const bf16_t* OH0; const float* GN; const float* ssq; bf16_t* Y;
    __device__ __forceinline__ void operator()(const pg8::Acc& acc, const Unit& u, int wr, int wc, int fr, int fq) const {
        asm volatile("" : "+v"(fr), "+v"(fq));
        const int b = u.pm >> 4, N = u.pm & 15, h = u.pn >> 1, eh = u.pn & 1, p = (b * 4 + h) * 16 + N, cb = wc * 32 + 8 * fq;
        const int row0 = u.pm * 256 + wr * 64 + fr;
        float ri[2][4]; rinv_rows(ssq, row0, fq, ri);
        const bf16_t* ob = eh == 0 ? OH0 + (size_t)p * 65536 : SQ + (size_t)p * SQ_P; const int pitch = eh == 0 ? 256 : 512;
#pragma unroll
        for (int ai = 0; ai < 2; ++ai)
#pragma unroll
            for (int m = 0; m < 4; ++m) { const int i = ai * 128 + wr * 64 + m * 16 + fr; const size_t tok = (size_t)row0 + ai * 128 + m * 16;
                const f32x4 st = *(const f32x4*)(GN + (tok * 4 + h) * 16 + fq * 4); float s = st[0] + st[2], q = st[1] + st[3];
                s += __shfl_xor(s, 16); s += __shfl_xor(s, 32); q += __shfl_xor(q, 16); q += __shfl_xor(q, 32);
                const float mu = s * (1.0f / RDV), var = fmaxf(q * (1.0f / RDV) - mu * mu, 0.f), rstd = 1.0f / sqrtf(var + GN_EPS), rr = ri[ai][m];
#pragma unroll
                for (int bj = 0; bj < 2; ++bj) { const u32x4 ow = *(const u32x4*)(ob + (size_t)i * pitch + bj * 128 + cb); f32x4 a = acc[ai][bj][m][0] * rr, c = acc[ai][bj][m][1] * rr;
                    const float o8[8] = {bf_lo(ow.x), bf_hi(ow.x), bf_lo(ow.y), bf_hi(ow.y), bf_lo(ow.z), bf_hi(ow.z), bf_lo(ow.w), bf_hi(ow.w)};
#pragma unroll
                    for (int e = 0; e < 4; ++e) { const float g0 = a[e], g1 = c[e];
                        a[e] = g0 * __builtin_amdgcn_rcpf(1.f + __builtin_amdgcn_exp2f(-g0 * LOG2E)) * ((o8[e] - mu) * rstd);
                        c[e] = g1 * __builtin_amdgcn_rcpf(1.f + __builtin_amdgcn_exp2f(-g1 * LOG2E)) * ((o8[4 + e] - mu) * rstd); }
                    *(u32x4*)(Y + tok * 2048 + h * 512 + eh * 256 + bj * 128 + cb) = pack8(a, c); }
                asm volatile("" ::: "memory"); }
    }
};

struct KVOrder { int G, c; const char* VS; const char* SQ;
    __device__ __forceinline__ bool next(int i, Unit& u) const { const int p = c + (i >> 1) * G; if (p >= NPROB) return false; u.p = p; u.pm = i & 1; u.pn = 0;
        u.a = VS + (size_t)p * VS_P * 2 + (size_t)u.pm * 256 * 512 * 2; u.b = SQ + (size_t)p * SQ_P * 2; return true; } };
struct SOrder { int G, c; const char* SQ; const char* KN;
    __device__ __forceinline__ bool next(int i, Unit& u) const { const int p = c + i * G; if (p >= NPROB) return false; u.p = p; u.pm = 0; u.pn = 0;
        const int bh = p >> 4, N = p & 15, b = bh >> 2, h = bh & 3; u.a = SQ + (size_t)p * SQ_P * 2 + 512; u.b = KN + ((size_t)(b * SEQ + N * 256) * 1024 + h * 256) * 2; return true; } };
struct OOrder { int G, c; const char* SQ; const char* VS;
    __device__ __forceinline__ bool next(int i, Unit& u) const { const int p = c + (i >> 1) * G; if (p >= NPROB) return false; u.p = p; u.pm = 0; u.pn = i & 1;
        u.a = SQ + (size_t)p * SQ_P * 2; u.b = VS + (size_t)p * VS_P * 2 + (size_t)u.pn * 256 * 512 * 2; return true; } };

#define XB_TMO      128
#define XB_XCNT(j)  (256  + 64 * (j))
#define XB_XSUB(j)  (1280 + 64 * (j))
#define XB_XGEN(j)  (2304 + 64 * (j))
#define XB_TOP      3328
#define XB_TOPGEN   3392
#define XCD_BAR_WORDS 3456
#define XB_SPIN_CAP (1u << 18)
__device__ __forceinline__ unsigned xb_ld(unsigned* p)              { return __hip_atomic_load(p, __ATOMIC_RELAXED, __HIP_MEMORY_SCOPE_AGENT); }
__device__ __forceinline__ unsigned xb_add(unsigned* p, unsigned v) { return __hip_atomic_fetch_add(p, v, __ATOMIC_RELAXED, __HIP_MEMORY_SCOPE_AGENT); }
__device__ __forceinline__ unsigned xb_xcc_id() { return (unsigned)__builtin_amdgcn_s_getreg((3 << 11) | 20) & 0xFu; }
#define XB_SPIN(cond, bar) do { unsigned _sp = 0; while (cond) { __builtin_amdgcn_s_sleep(1); \
    if ((++_sp & 255u) == 0u) { if (xb_ld(&(bar)[XB_TMO])) break; if (_sp > XB_SPIN_CAP) { atomicAdd(&(bar)[XB_TMO], 1u); break; } } } } while (0)
struct XcdBarrier { unsigned* bar; unsigned x; volatile LAS unsigned* st; };
__device__ __forceinline__ XcdBarrier xcd_barrier_post(unsigned* bar, volatile LAS unsigned* st) {
    XcdBarrier b; b.bar = bar; b.x = xb_xcc_id(); b.st = st;
    if (threadIdx.x == 0) (void)xb_add(&bar[XB_XCNT(b.x)], 1u);
    return b;
}
__device__ __forceinline__ void xcd_barrier_complete(unsigned* bar, unsigned x, unsigned& nloc, unsigned& nx) {
    const unsigned G = gridDim.x * gridDim.y * gridDim.z;
    unsigned sum, cnt, mine, sp = 0u;
    for (;;) {
        sum = 0u; cnt = 0u; mine = 0u;
#pragma unroll
        for (unsigned j = 0; j < 16; ++j) { const unsigned c = xb_ld(&bar[XB_XCNT(j)]); sum += c; cnt += (c > 0u) ? 1u : 0u; mine = (j == x) ? c : mine; }
        if (sum == G) break;
        __builtin_amdgcn_s_sleep(1);
        if ((++sp & 255u) == 0u) { if (xb_ld(&bar[XB_TMO])) break; if (sp > XB_SPIN_CAP) { atomicAdd(&bar[XB_TMO], 1u); break; } }
    }
    nloc = mine > 0u ? mine : 1u; nx = cnt > 0u ? cnt : 1u;
}
__device__ __forceinline__ void xcd_barrier(const XcdBarrier& b) {
    asm volatile("s_waitcnt vmcnt(0)" ::: "memory");
    __syncthreads();
    if (threadIdx.x == 0) {
        unsigned* bar = b.bar;
        __builtin_amdgcn_s_waitcnt(0);
        unsigned nloc = b.st[0], nx = b.st[1];
        if (nloc == 0u) { xcd_barrier_complete(bar, b.x, nloc, nx); b.st[0] = nloc; b.st[1] = nx; }
        const unsigned old = xb_add(&bar[XB_XSUB(b.x)], 1u);
        const unsigned gen = old / nloc;
        if (old + 1u == (gen + 1u) * nloc) {
            __builtin_amdgcn_fence(__ATOMIC_RELEASE, "agent");
            asm volatile("s_waitcnt vmcnt(0)" ::: "memory");
            const unsigned og = xb_add(&bar[XB_TOP], 1u);
            const unsigned tg = og / nx;
            if (og + 1u == (tg + 1u) * nx) xb_add(&bar[XB_TOPGEN], 1u);
            else XB_SPIN(xb_ld(&bar[XB_TOPGEN]) == tg, bar);
            __builtin_amdgcn_fence(__ATOMIC_ACQUIRE, "agent");
            xb_add(&bar[XB_XGEN(b.x)], 1u);
            asm volatile("s_waitcnt vmcnt(0)" ::: "memory");
        } else {
            XB_SPIN(xb_ld(&bar[XB_XGEN(b.x)]) == gen, bar);
            __builtin_amdgcn_fence(__ATOMIC_ACQUIRE, "agent");
            asm volatile("s_waitcnt vmcnt(0)" ::: "memory");
        }
    }
    __syncthreads();
}

__device__ __forceinline__ void transpose_item(const float* W, const float* g, int K, int N, bf16_t* WT, LAS float* scr, int item, int lane) {
    const int nblk = N / 32, kb = item / nblk, nb = item % nblk, k0 = 64 * kb, n0 = 32 * nb;
#pragma unroll 8
    for (int i = 0; i < 32; ++i) { const int kk = 2 * i + (lane >> 5); const float gv = g ? g[k0 + kk] : 1.f; scr[kk * 33 + (lane & 31)] = W[(size_t)(k0 + kk) * N + n0 + (lane & 31)] * gv; }
    LDS_WAIT(); asm volatile("" ::: "memory");
    const int c = lane & 7;
#pragma unroll
    for (int j = 0; j < 4; ++j) { const int n = (lane >> 3) + 8 * j; const LAS float* s = scr + (8 * c) * 33 + n;
        u32x4 o; o.x = cvt_pk_bf16(s[0 * 33], s[1 * 33]); o.y = cvt_pk_bf16(s[2 * 33], s[3 * 33]); o.z = cvt_pk_bf16(s[4 * 33], s[5 * 33]); o.w = cvt_pk_bf16(s[6 * 33], s[7 * 33]);
        *(u32x4*)(WT + (size_t)(n0 + n) * K + k0 + 8 * c) = o; }
    LDS_WAIT(); asm volatile("" ::: "memory");
}
__device__ __forceinline__ void convert_pair(const float* W0, const float* g0, int K0, int N0, bf16_t* T0, const float* W1, const float* g1, int K1, int N1, bf16_t* T1, LAS unsigned char* lds, int gw, int ngw, int wave, int lane) {
    LAS float* scr = (LAS float*)(lds + wave * 16384);
    const int I0 = (K0 / 64) * (N0 / 32), I1 = (K1 / 64) * (N1 / 32);
    for (int it = gw; it < I0 + I1; it += ngw) { if (it < I0) transpose_item(W0, g0, K0, N0, T0, scr, it, lane); else transpose_item(W1, g1, K1, N1, T1, scr, it - I0, lane); }
    __syncthreads();
}
__device__ __forceinline__ void convert_mix(int L, const float* const* in, unsigned char* ws, LAS unsigned char* lds, int gw, int ngw, int wave, int lane) {
    const int i = L >> 1; const float* g = in[5] + (size_t)L * D; bf16_t* T = (bf16_t*)(ws + WS_WMIX);
    if ((L & 1) == 0) convert_pair(in[1] + (size_t)i * D * 3 * D, g, D, 3 * D, T, in[2] + (size_t)i * D * D, nullptr, D, D, T + (size_t)3 * D * D, lds, gw, ngw, wave, lane);
    else convert_pair(in[3] + (size_t)i * D * 6 * D, g, D, 6 * D, T, in[4] + (size_t)i * 2 * D * D, nullptr, 2 * D, D, T + (size_t)6 * D * D, lds, gw, ngw, wave, lane);
}
__device__ __forceinline__ void convert_mlp(int L, const float* const* in, unsigned char* ws, LAS unsigned char* lds, int gw, int ngw, int wave, int lane) {
    bf16_t* T = (bf16_t*)(ws + WS_WMLP);
    convert_pair(in[7] + (size_t)L * D * FF, in[6] + (size_t)L * D, D, FF, T, in[8] + (size_t)L * FF * D, nullptr, FF, D, T + (size_t)FF * D, lds, gw, ngw, wave, lane);
}
__device__ __forceinline__ void p0_rows(const float* x, bf16_t* hbf, float* ssq, int gw, int ngw, int lane) {
    for (int m = gw; m < M; m += ngw) { const f32x4* xr = (const f32x4*)(x + (size_t)m * D) + lane; f32x4 v[4]; float s = 0.f;
#pragma unroll
        for (int j = 0; j < 4; ++j) { v[j] = xr[64 * j]; s += (v[j][0] * v[j][0] + v[j][1] * v[j][1]) + (v[j][2] * v[j][2] + v[j][3] * v[j][3]); }
        s = wave_sum(s);
        u32x2* o8 = (u32x2*)(hbf + (size_t)m * D) + lane;
#pragma unroll
        for (int j = 0; j < 4; ++j) { u32x2 w; w.x = cvt_pk_bf16(v[j][0], v[j][1]); w.y = cvt_pk_bf16(v[j][2], v[j][3]); o8[64 * j] = w; }
        if (lane < 16) ssq[(size_t)m * 16 + lane] = lane == 0 ? s : 0.f; }
}
__device__ __forceinline__ void final_rows(float* out, const float* ssq, const float* gf, int gw, int ngw, int lane) {
    for (int m = gw; m < M; m += ngw) { float s = ssq[(size_t)m * 16 + (lane & 15)]; s += __shfl_xor(s, 1); s += __shfl_xor(s, 2); s += __shfl_xor(s, 4); s += __shfl_xor(s, 8);
        const float r = rinv_of(s); f32x4* xr = (f32x4*)(out + (size_t)m * D) + lane; const f32x4* gr = (const f32x4*)gf + lane;
#pragma unroll
        for (int j = 0; j < 4; ++j) xr[64 * j] = xr[64 * j] * r * gr[64 * j]; }
}
__device__ __forceinline__ void ret_scan(bf16_t* VS, int gtid, int gthreads) {
    for (int g = gtid; g < BATCH * RH * RDV * 32; g += gthreads) { const int bh = g >> 14, rem = g & 16383, e = rem >> 5, dg = rem & 31, h = bh & 3;
        const float dec = __builtin_amdgcn_exp2f(256.f * lg2gamma(h));
        bf16_t* p = VS + (size_t)bh * 16 * VS_P + (size_t)e * 512 + 256 + dg * 8; float st[8];
#pragma unroll
        for (int k = 0; k < 8; ++k) st[k] = 0.f;
        u32x4 w[16];
#pragma unroll
        for (int N = 0; N < 16; ++N) w[N] = *(const u32x4*)(p + (size_t)N * VS_P);
#pragma unroll
        for (int N = 0; N < 16; ++N) { u32x4 o; o.x = cvt_pk_bf16(st[0], st[1]); o.y = cvt_pk_bf16(st[2], st[3]); o.z = cvt_pk_bf16(st[4], st[5]); o.w = cvt_pk_bf16(st[6], st[7]);
            *(u32x4*)(p + (size_t)N * VS_P) = o;
            st[0] = dec * st[0] + bf_lo(w[N].x); st[1] = dec * st[1] + bf_hi(w[N].x); st[2] = dec * st[2] + bf_lo(w[N].y); st[3] = dec * st[3] + bf_hi(w[N].y);
            st[4] = dec * st[4] + bf_lo(w[N].z); st[5] = dec * st[5] + bf_hi(w[N].z); st[6] = dec * st[6] + bf_lo(w[N].w); st[7] = dec * st[7] + bf_hi(w[N].w); } }
}
__device__ __forceinline__ void sb_attn_simple(const bf16_t* Q, const bf16_t* K, const bf16_t* V, bf16_t* O, int gw, int ngw, int lane) {
    for (int task = gw; task < BATCH * SBH * (SEQ / 64); task += ngw) {
        const int bh = task >> 6, qb = task & 63, b = bh >> 4, h = bh & 15, q0 = qb * 64, t = q0 + lane;
        const size_t rowoff = ((size_t)b * SEQ + t) * D + h * SBD;
        float q[64], o[64];
#pragma unroll
        for (int i = 0; i < 8; ++i) { const u32x4 w = *(const u32x4*)(Q + rowoff + i * 8); q[8 * i + 0] = bf_lo(w.x); q[8 * i + 1] = bf_hi(w.x); q[8 * i + 2] = bf_lo(w.y); q[8 * i + 3] = bf_hi(w.y);
            q[8 * i + 4] = bf_lo(w.z); q[8 * i + 5] = bf_hi(w.z); q[8 * i + 6] = bf_lo(w.w); q[8 * i + 7] = bf_hi(w.w); }
#pragma unroll
        for (int i = 0; i < 64; ++i) o[i] = 0.f;
        float carry = 0.f;
        const bf16_t* Kb = K + (size_t)b * SEQ * D + h * SBD; const bf16_t* Vb = V + (size_t)b * SEQ * D + h * SBD;
        for (int s = q0 + 62; s >= 0; --s) {
            const u32x4* kr = (const u32x4*)(Kb + (size_t)s * D); float z0 = 0.f, z1 = 0.f;
#pragma unroll
            for (int i = 0; i < 8; ++i) { const u32x4 w = kr[i];
                z0 += q[8 * i + 0] * bf_lo(w.x); z1 += q[8 * i + 1] * bf_hi(w.x); z0 += q[8 * i + 2] * bf_lo(w.y); z1 += q[8 * i + 3] * bf_hi(w.y);
                z0 += q[8 * i + 4] * bf_lo(w.z); z1 += q[8 * i + 5] * bf_hi(w.z); z0 += q[8 * i + 6] * bf_lo(w.w); z1 += q[8 * i + 7] * bf_hi(w.w); }
            const float z = z0 + z1;
            const float l = __builtin_amdgcn_logf(1.f + __builtin_amdgcn_exp2f(-fabsf(z)));
            const float lk = -(fmaxf(z, 0.f) + l);
            const bool valid = s < t;
            const float a = valid ? __builtin_amdgcn_exp2f((z + lk) + carry) : 0.f;
            carry += valid ? lk : 0.f;
            const u32x4* vr = (const u32x4*)(Vb + (size_t)s * D);
#pragma unroll
            for (int i = 0; i < 8; ++i) { const u32x4 w = vr[i];
                o[8 * i + 0] += a * bf_lo(w.x); o[8 * i + 1] += a * bf_hi(w.x); o[8 * i + 2] += a * bf_lo(w.y); o[8 * i + 3] += a * bf_hi(w.y);
                o[8 * i + 4] += a * bf_lo(w.z); o[8 * i + 5] += a * bf_hi(w.z); o[8 * i + 6] += a * bf_lo(w.w); o[8 * i + 7] += a * bf_hi(w.w); }
            if (__all(carry < -152.f)) break;
        }
#pragma unroll
        for (int i = 0; i < 8; ++i) { u32x4 w; w.x = cvt_pk_bf16(o[8 * i + 0], o[8 * i + 1]); w.y = cvt_pk_bf16(o[8 * i + 2], o[8 * i + 3]); w.z = cvt_pk_bf16(o[8 * i + 4], o[8 * i + 5]); w.w = cvt_pk_bf16(o[8 * i + 6], o[8 * i + 7]);
            *(u32x4*)(O + rowoff + i * 8) = w; }
    }
}

struct Args { const float* in[10]; float* out; unsigned char* ws; };
struct Ctx { LAS unsigned char* lds; unsigned char* ws; const float* const* in; float* out; int G, bx, gw, ngw, wave, lane, tid; };

template <int L> __device__ __forceinline__ void layer(const Ctx& c, const XcdBarrier& bar) {
    LAS unsigned char* lds = c.lds; unsigned char* ws = c.ws; const int G = c.G, bx = c.bx;
    const float* x = c.in[0]; float* out = c.out;
    float* ssq = (float*)(ws + WS_SSQ); float* GN = (float*)(ws + WS_GN);
    bf16_t* hbf = (bf16_t*)(ws + WS_HBF); bf16_t* wmix = (bf16_t*)(ws + WS_WMIX); bf16_t* wmlp = (bf16_t*)(ws + WS_WMLP);
    const float* base = (L == 0) ? x : out;
    if constexpr ((L & 1) == 0) {
        bf16_t* Qb = (bf16_t*)(ws + WS_Q); bf16_t* Kb = (bf16_t*)(ws + WS_K); bf16_t* Vb = (bf16_t*)(ws + WS_V);
        { pg8::StdOrder S; S.init(M, 3 * D, G, bx, hbf, wmix, D, D); EpiQKV E{Qb, ssq};
          pg8::gemm_phase<EpiQKV, pg8::StdOrder, D, D, D, true>(lds, S, E); }
        xcd_barrier(bar);
        sb_attn_simple(Qb, Kb, Vb, Qb, c.gw, c.ngw, c.lane);
        xcd_barrier(bar);
        convert_mlp(L, c.in, ws, lds, c.gw, c.ngw, c.wave, c.lane);
        { pg8::StdOrder S; S.init(M, D, G, bx, Qb, wmix + (size_t)3 * D * D, D, D); EpiRes E{base, out, hbf, ssq};
          pg8::gemm_phase<EpiRes, pg8::StdOrder, D, D, D, false>(lds, S, E); }
        xcd_barrier(bar);
    } else {
        bf16_t* SQ = (bf16_t*)(ws + WS_SQ); bf16_t* VS = (bf16_t*)(ws + WS_VS); bf16_t* KN = (bf16_t*)(ws + WS_KN); bf16_t* Y = (bf16_t*)(ws + WS_Y);
        { pg8::StdOrder S; S.init(M, 2 * D, G, bx, hbf, wmix, D, D); EpiRetQK E{SQ, KN, ssq};
          pg8::gemm_phase<EpiRetQK, pg8::StdOrder, D, D, D, true>(lds, S, E); }
        { pg8::StdOrder S; S.init(3 * D, M, G, bx, wmix + (size_t)D * D, hbf, D, D); EpiRetKVt E{SQ, VS, ssq};
          pg8::gemm_phase<EpiRetKVt, pg8::StdOrder, D, D, D, true>(lds, S, E); }
        xcd_barrier(bar);
        { KVOrder S{G, bx, (const char*)VS, (const char*)SQ}; EpiKV E{VS};
          pg8::gemm_phase<EpiKV, KVOrder, 512, 512, 256, true>(lds, S, E); }
        { SOrder S{G, bx, (const char*)SQ, (const char*)KN}; EpiS E{SQ};
          pg8::gemm_phase<EpiS, SOrder, 512, 1024, 256, true>(lds, S, E); }
        xcd_barrier(bar);
        ret_scan(VS, bx * NWAVES * 64 + c.tid, G * NWAVES * 64);
        xcd_barrier(bar);
        { OOrder S{G, bx, (const char*)SQ, (const char*)VS}; EpiO E{SQ, KN, GN};
          pg8::gemm_phase<EpiO, OOrder, 512, 512, 512, true>(lds, S, E); }
        xcd_barrier(bar);
        { pg8::StdOrder S; S.init(M, 2 * D, G, bx, hbf, wmix + (size_t)4 * D * D, D, D); EpiG E{SQ, KN, GN, ssq, Y};
          pg8::gemm_phase<EpiG, pg8::StdOrder, D, D, D, true>(lds, S, E); }
        xcd_barrier(bar);
        convert_mlp(L, c.in, ws, lds, c.gw, c.ngw, c.wave, c.lane);
        { pg8::StdOrder S; S.init(M, D, G, bx, Y, wmix + (size_t)6 * D * D, 2 * D, 2 * D); EpiRes E{base, out, hbf, ssq};
          pg8::gemm_phase<EpiRes, pg8::StdOrder, 2 * D, 2 * D, 2 * D, false>(lds, S, E); }
        xcd_barrier(bar);
    }
    bf16_t* U = (bf16_t*)(ws + WS_U);
    { pg8::StdOrder S; S.init(M, FF, G, bx, hbf, wmlp, D, D); EpiUp E{U, ssq};
      pg8::gemm_phase<EpiUp, pg8::StdOrder, D, D, D, true>(lds, S, E); }
    xcd_barrier(bar);
    if constexpr (L + 1 < NLAYER) convert_mix(L + 1, c.in, ws, lds, c.gw, c.ngw, c.wave, c.lane);
    { pg8::StdOrder S; S.init(M, D, G, bx, U, wmlp + (size_t)FF * D, FF, FF); EpiRes E{out, out, hbf, ssq};
      pg8::gemm_phase<EpiRes, pg8::StdOrder, FF, FF, FF, false>(lds, S, E); }
    xcd_barrier(bar);
}

__global__ void __launch_bounds__(NWAVES * 64, 2) trunk_fwd(Args args) {
    extern __shared__ __attribute__((aligned(16))) unsigned char lds_raw[];
    LAS unsigned char* lds = (LAS unsigned char*)lds_raw;
    volatile LAS unsigned* MISC = (volatile LAS unsigned*)(lds + MISC_OFF);
    const int tid = threadIdx.x, lane = tid & 63, wave = __builtin_amdgcn_readfirstlane(tid >> 6);
    const int G = gridDim.x, bx = blockIdx.x;
    const int gw = bx * NWAVES + wave, ngw = G * NWAVES;
    unsigned char* ws = args.ws;
    unsigned* ctl = (unsigned*)(ws + WS_CTL);
    for (int u = tid; u < (LDS_BYTES - LDSCTL_OFF) / 4; u += NWAVES * 64) ((LAS unsigned*)(lds + LDSCTL_OFF))[u] = 0u;
    __syncthreads();
    const XcdBarrier bar = xcd_barrier_post(ctl + 4096, MISC + 8);
    const Ctx c{lds, ws, args.in, args.out, G, bx, gw, ngw, wave, lane, tid};

    p0_rows(args.in[0], (bf16_t*)(ws + WS_HBF), (float*)(ws + WS_SSQ), gw, ngw, lane);
    convert_mix(0, args.in, ws, lds, gw, ngw, wave, lane);
    xcd_barrier(bar);
    layer<0>(c, bar); layer<1>(c, bar); layer<2>(c, bar); layer<3>(c, bar);
    { int lane_f = lane; asm volatile("" : "+v"(lane_f));
      final_rows(args.out, (const float*)(ws + WS_SSQ), args.in[9], gw, ngw, lane_f); }
}

extern "C" void kernel_launch(void* const* d_in, const int* in_sizes, int n_in, void* d_out, int out_size, void* d_ws, size_t ws_size, hipStream_t stream) {
    static int grid = 0;
    if (grid == 0) {
        if (n_in != 10 || in_sizes[0] != M * D || out_size != M * D || ws_size < WS_END) { fprintf(stderr, "kernel_launch: unexpected shapes / workspace (%d inputs, ws %zu < %zu)\n", n_in, ws_size, (size_t)WS_END); grid = -1; return; }
        int dev = 0, cus = 0, per_cu = 0;
        if (hipGetDevice(&dev) != hipSuccess || hipDeviceGetAttribute(&cus, hipDeviceAttributeMultiprocessorCount, dev) != hipSuccess) { grid = -1; return; }
        if (hipFuncSetAttribute((const void*)trunk_fwd, hipFuncAttributeMaxDynamicSharedMemorySize, LDS_BYTES) != hipSuccess) { fprintf(stderr, "kernel_launch: hipFuncSetAttribute failed\n"); grid = -1; return; }
        if (hipOccupancyMaxActiveBlocksPerMultiprocessor(&per_cu, (const void*)trunk_fwd, NWAVES * 64, LDS_BYTES) != hipSuccess || per_cu < 1) fprintf(stderr, "kernel_launch: occupancy query reports %d\n", per_cu);
        (void)hipGetLastError();
        grid = cus;
    }
    if (grid < 0) return;
    if (hipMemsetAsync((char*)d_ws + WS_CTL, 0, CTL_ZERO_BYTES, stream) != hipSuccess) return;
    Args a{};
    for (int i = 0; i < 10; ++i) a.in[i] = (const float*)d_in[i];
    a.out = (float*)d_out; a.ws = (unsigned char*)d_ws;
    hipLaunchKernelGGL(trunk_fwd, dim3(grid), dim3(NWAVES * 64), LDS_BYTES, stream, a);
}
```

```cpp
#include <hip/hip_runtime.h>
#include <cstdio>
#include <cstdint>

#define PG8_LAS __attribute__((address_space(3)))
#define GAS __attribute__((address_space(1)))
#define LAS __attribute__((address_space(3)))
typedef unsigned short bf16_t;
typedef short bf16x8 __attribute__((ext_vector_type(8)));
typedef float f32x4 __attribute__((ext_vector_type(4)));
typedef float f32x2 __attribute__((ext_vector_type(2)));
typedef unsigned u32x4 __attribute__((ext_vector_type(4)));
typedef unsigned u32x2 __attribute__((ext_vector_type(2)));

constexpr int BATCH = 4, SEQ = 4096, D = 1024, FF = 4096, NLAYER = 4;
constexpr int M = BATCH * SEQ;
constexpr int SBH = 16, SBD = 64;
constexpr int RH = 4, RDK = 256, RDV = 512, RC = 256, RNC = SEQ / RC;
constexpr int NPROB = BATCH * RH * RNC;
constexpr float RMS_EPS = 1e-6f, GN_EPS = 1e-6f;
constexpr float C2 = 0.18033688011112042f;
constexpr float L2B127 = 0.10462765653188542f;
constexpr float INV2PI = 0.15915494309189535f;
constexpr float LOG2E = 1.4426950408889634f;
__device__ __forceinline__ float lg2gamma(int h) { return h == 0 ? -0.04580368961312479f : (h == 1 ? -0.02272007650008353f : (h == 2 ? -0.011315313227834146f : -0.005646563141142063f)); }

constexpr size_t MiB = 1u << 20;
constexpr size_t WS_CTL = 0, CTL_ZERO_BYTES = 1 * MiB;
constexpr size_t WS_SSQ = 1 * MiB;
constexpr size_t WS_GN = 2 * MiB;
constexpr size_t WS_HBF = 6 * MiB;
constexpr size_t WS_WMIX = 38 * MiB;
constexpr size_t WS_SCR = 54 * MiB;
constexpr size_t WS_Q = WS_SCR, WS_K = WS_SCR + 32 * MiB, WS_V = WS_SCR + 64 * MiB;
constexpr size_t WS_SQ = WS_SCR;
constexpr size_t WS_VS = WS_SCR + 64 * MiB;
constexpr size_t WS_KN = WS_SCR + 192 * MiB;
constexpr size_t WS_Y = WS_VS;
constexpr size_t WS_U = WS_SCR;
constexpr size_t WS_WMLP = WS_SCR + 192 * MiB;
constexpr size_t WS_END = WS_SCR + 224 * MiB;
constexpr size_t SQ_P = 256 * 512, VS_P = 512 * 512;

constexpr int RING_BYTES = 131072, LDSCTL_OFF = RING_BYTES, MISC_OFF = LDSCTL_OFF + 320, LDS_BYTES = 147456;
constexpr int NWAVES = 8;

__device__ __forceinline__ unsigned cvt_pk_bf16(float lo, float hi) { unsigned r; asm volatile("v_cvt_pk_bf16_f32 %0, %1, %2" : "=v"(r) : "v"(lo), "v"(hi)); return r; }
__device__ __forceinline__ float bf_lo(unsigned w) { return __uint_as_float(w << 16); }
__device__ __forceinline__ float bf_hi(unsigned w) { return __uint_as_float(w & 0xffff0000u); }
__device__ __forceinline__ u32x4 pack8(f32x4 a, f32x4 b) { u32x4 w; w.x = cvt_pk_bf16(a[0], a[1]); w.y = cvt_pk_bf16(a[2], a[3]); w.z = cvt_pk_bf16(b[0], b[1]); w.w = cvt_pk_bf16(b[2], b[3]); return w; }
__device__ __forceinline__ float wave_sum(float v) {
#pragma unroll
    for (int o = 1; o < 64; o <<= 1) v += __shfl_xor(v, o);
    return v;
}
__device__ __forceinline__ float rinv_of(float ss) { return 1.0f / sqrtf(ss * (1.0f / D) + RMS_EPS); }
#define LDS_WAIT() asm volatile("s_waitcnt lgkmcnt(0)" ::: "memory")
#define VM_WAIT() asm volatile("s_waitcnt vmcnt(0)" ::: "memory")

namespace pg8 {
constexpr int BM = 256, BK = 64, HALF = 128, HTB = HALF * BK * 2, STAGE_BYTES = 8 * HTB, NXCD = 8, WGM = 8;
__host__ __device__ __forceinline__ int lds_byte(int r, int c) { const int st = (r >> 4) * 2 + (c >> 5), rr = r & 15, cc = c & 31, ob = rr * 64 + cc * 2; return st * 1024 + (ob ^ (((ob >> 9) & 1) << 5)); }
__host__ __device__ __forceinline__ void stage_rc(int b, int& R, int& C) { const int st = b / 1024, sb = b % 1024, swz = sb ^ (((sb >> 9) & 1) << 5); R = (st >> 1) * 16 + swz / 64; C = (st & 1) * 32 + (swz % 64) / 2; }
__host__ __device__ __forceinline__ int perm32(int rho) { const int n = rho >> 4, i = rho & 15; return 8 * (i >> 2) + 4 * n + (i & 3); }

struct Unit { int pm, pn, p; const char* a; const char* b; };

struct StdOrder {
    int nM, nN, nwg, G, c; const char* A; const char* B; size_t tA, tB;
    __device__ __forceinline__ void init(int Mr, int Nc, int G_, int c_, const void* A_, const void* B_, int lda, int ldb) { nM = Mr / BM; nN = Nc / BM; nwg = nM * nN; G = G_; c = c_; A = (const char*)A_; B = (const char*)B_; tA = (size_t)BM * lda * 2; tB = (size_t)BM * ldb * 2; }
    __device__ __forceinline__ bool next(int i, Unit& u) const {
        const long L = (long)i * G + c; if (L >= nwg) return false;
        int wgid = (int)L; { const int q = nwg / NXCD, r = nwg % NXCD, xcd = wgid % NXCD, off = wgid / NXCD; wgid = (xcd < r ? xcd * (q + 1) : r * (q + 1) + (xcd - r) * q) + off; }
        const int nig = WGM * nN, gid = wgid / nig, fm = gid * WGM, gsz = (nM - fm) < WGM ? (nM - fm) : WGM;
        u.pm = fm + ((wgid % nig) % gsz); u.pn = (wgid % nig) / gsz; u.p = 0; u.a = A + (size_t)u.pm * tA; u.b = B + (size_t)u.pn * tB; return true;
    }
};

template <class Epi, class Sched, int LDA, int LDB, int KD, bool ALIGN_EPI>
__device__ __forceinline__ void gemm_phase(PG8_LAS unsigned char* lds, const Sched& S, const Epi& E) {
    int tid = threadIdx.x; asm volatile("" : "+v"(tid));
    const int wid = __builtin_amdgcn_readfirstlane(tid >> 6), lane = tid & 63, wr = wid >> 2, wc = wid & 3, fr = lane & 15, fq = lane >> 4;
    constexpr int nt = KD / BK;
    static_assert(KD % 128 == 0 && KD >= 256, "K multiple of 128, >= 256");
    unsigned voffA[2], voffB[2];
#pragma unroll
    for (int i = 0; i < 2; ++i) { int R, C; stage_rc(tid * 16 + i * 8192, R, C); const int Rb = (R & ~31) + perm32(R & 31);
        voffA[i] = (unsigned)(R * LDA + C) * 2u; voffB[i] = (unsigned)(Rb * LDB + C) * 2u; }
    constexpr size_t kstep = (size_t)(BK * 2), hstepA = (size_t)HALF * LDA * 2, hstepB = (size_t)HALF * LDB * 2;
    const unsigned ldsw = (unsigned)wid * 1024u;
    const int aoff = lds_byte(wr * 64 + fr, fq * 8), boff = lds_byte(wc * 32 + fr, fq * 8);
#define PG8_SA(b, h) (((b) * 2 + (h)) * HTB)
#define PG8_SB(b, h) ((4 + (b) * 2 + (h)) * HTB)
#define PG8_STAGE(bufoff, gbase, voff) do { _Pragma("unroll") for (int _i = 0; _i < 2; ++_i) \
        __builtin_amdgcn_global_load_lds((const unsigned*)((const char*)(gbase) + (voff)[_i]), (PG8_LAS unsigned*)(lds + (bufoff) + ldsw + _i * 8192), 16, 0, 0); } while (0)
#define PG8_LDA(dst, b, h) do { _Pragma("unroll") for (int m = 0; m < 4; ++m) _Pragma("unroll") for (int k = 0; k < 2; ++k) dst[m][k] = *(const PG8_LAS bf16x8*)(lds + PG8_SA(b, h) + aoff + m * 2048 + k * 1024); } while (0)
#define PG8_LDB(dst, b, h) do { _Pragma("unroll") for (int n = 0; n < 2; ++n) _Pragma("unroll") for (int k = 0; k < 2; ++k) dst[n][k] = *(const PG8_LAS bf16x8*)(lds + PG8_SB(b, h) + boff + n * 2048 + k * 1024); } while (0)
#define PG8_MMA(ai, bj, At, Bt) do { __builtin_amdgcn_s_setprio(1); _Pragma("unroll") for (int m = 0; m < 4; ++m) _Pragma("unroll") for (int n = 0; n < 2; ++n) _Pragma("unroll") for (int k = 0; k < 2; ++k) \
        acc[ai][bj][m][n] = __builtin_amdgcn_mfma_f32_16x16x32_bf16(Bt[n][k], At[m][k], acc[ai][bj][m][n], 0, 0, 0); __builtin_amdgcn_s_setprio(0); } while (0)
#define PG8_WAIT_V(n) asm volatile("s_waitcnt vmcnt(" #n ")" ::: "memory")
#define PG8_WAIT_L(n) asm volatile("s_waitcnt lgkmcnt(" #n ")" ::: "memory")
#define PG8_BAR __builtin_amdgcn_s_barrier()
#define PG8_SCHED __builtin_amdgcn_sched_barrier(0)
    Unit cur, nxt; int ui = 0;
    if (!S.next(0, cur)) return;
    f32x4 acc[2][2][4][2];
#pragma unroll
    for (int a = 0; a < 2; ++a)
#pragma unroll
        for (int b = 0; b < 2; ++b)
#pragma unroll
            for (int m = 0; m < 4; ++m)
#pragma unroll
                for (int n = 0; n < 2; ++n) acc[a][b][m][n] = (f32x4){0.f, 0.f, 0.f, 0.f};
    bf16x8 At[4][2], B0[2][2], B1[2][2];
    const char* cA = cur.a; const char* cB = cur.b;
    PG8_STAGE(PG8_SB(0, 0), cB, voffB); PG8_STAGE(PG8_SB(0, 1), cB + hstepB, voffB); PG8_STAGE(PG8_SA(0, 0), cA, voffA); PG8_STAGE(PG8_SA(0, 1), cA + hstepA, voffA);
    if (wr == 1) PG8_BAR;
    PG8_WAIT_V(2); PG8_BAR;
    PG8_STAGE(PG8_SB(1, 0), cB + kstep, voffB); PG8_STAGE(PG8_SA(1, 0), cA + kstep, voffA); PG8_STAGE(PG8_SB(1, 1), cB + hstepB + kstep, voffB);
    PG8_WAIT_V(6); PG8_BAR;
    for (;;) {
        const bool has_next = S.next(ui + 1, nxt);
        const char* nA = has_next ? nxt.a : cA; const char* nB = has_next ? nxt.b : cB;
#pragma nounroll
        for (int t = 0; t < nt; t += 2) {
            const bool last = (t == nt - 2);
            const char* a1 = cA + (size_t)(t + 1) * kstep;
            const char* a2 = last ? nA : cA + (size_t)(t + 2) * kstep; const char* b2 = last ? nB : cB + (size_t)(t + 2) * kstep;
            const char* a3 = a2 + kstep; const char* b3 = b2 + kstep;
            PG8_LDB(B0, 0, 0); PG8_LDB(B1, 0, 1); PG8_SCHED; PG8_LDA(At, 0, 0); PG8_STAGE(PG8_SA(1, 1), a1 + hstepA, voffA);
            PG8_WAIT_V(8); PG8_WAIT_L(0); PG8_BAR; PG8_MMA(0, 0, At, B0); PG8_MMA(0, 1, At, B1); PG8_BAR; PG8_SCHED;
            PG8_LDA(At, 0, 1); PG8_STAGE(PG8_SB(0, 0), b2, voffB); PG8_STAGE(PG8_SB(0, 1), b2 + hstepB, voffB); PG8_STAGE(PG8_SA(0, 0), a2, voffA);
            PG8_WAIT_V(8); PG8_WAIT_L(0); PG8_BAR; PG8_MMA(1, 0, At, B0); PG8_MMA(1, 1, At, B1); PG8_BAR; PG8_SCHED;
            PG8_LDB(B0, 1, 0); PG8_LDB(B1, 1, 1); PG8_SCHED; PG8_LDA(At, 1, 0); PG8_STAGE(PG8_SA(0, 1), a2 + hstepA, voffA);
            PG8_WAIT_V(8); PG8_WAIT_L(0); PG8_BAR; PG8_MMA(0, 0, At, B0); PG8_MMA(0, 1, At, B1); PG8_BAR; PG8_SCHED;
            PG8_LDA(At, 1, 1); PG8_STAGE(PG8_SB(1, 0), b3, voffB); PG8_STAGE(PG8_SB(1, 1), b3 + hstepB, voffB); PG8_STAGE(PG8_SA(1, 0), a3, voffA);
            PG8_WAIT_V(8); PG8_WAIT_L(0); PG8_BAR; PG8_MMA(1, 0, At, B0); PG8_MMA(1, 1, At, B1); PG8_BAR; PG8_SCHED;
        }
        if constexpr (ALIGN_EPI) { if (wr == 0) PG8_BAR; }
        E(acc, cur, wr, wc, fr, fq);
        if (!has_next) break;
#pragma unroll
        for (int a = 0; a < 2; ++a)
#pragma unroll
            for (int b = 0; b < 2; ++b)
#pragma unroll
                for (int m = 0; m < 4; ++m)
#pragma unroll
                    for (int n = 0; n < 2; ++n) acc[a][b][m][n] = (f32x4){0.f, 0.f, 0.f, 0.f};
        cur = nxt; cA = nA; cB = nB; ++ui;
        if constexpr (ALIGN_EPI) { if (wr == 1) PG8_BAR; }
    }
    PG8_WAIT_V(0);
    if constexpr (!ALIGN_EPI) { if (wr == 0) PG8_BAR; }
    PG8_BAR;
#undef PG8_SA
#undef PG8_SB
#undef PG8_STAGE
#undef PG8_LDA
#undef PG8_LDB
#undef PG8_MMA
#undef PG8_WAIT_V
#undef PG8_WAIT_L
#undef PG8_BAR
#undef PG8_SCHED
}
typedef f32x4 Acc[2][2][4][2];
}
using pg8::Unit;

__device__ __forceinline__ void rinv_rows(const float* ssq, int rowbase, int fq, float (&ri)[2][4]) {
#pragma unroll
    for (int ai = 0; ai < 2; ++ai)
#pragma unroll
        for (int m = 0; m < 4; ++m) { const f32x4 v = *(const f32x4*)(ssq + (size_t)(rowbase + ai * 128 + m * 16) * 16 + fq * 4);
            float s = (v[0] + v[1]) + (v[2] + v[3]); s += __shfl_xor(s, 16); s += __shfl_xor(s, 32); ri[ai][m] = rinv_of(s); }
}
__device__ __forceinline__ void rinv_cols(const float* ssq, int colbase  , int fr, int lane, float (&rc)[2][8]) {
    const int tok = colbase + 128 * (fr >> 3) + (fr & 7); const f32x4* p = (const f32x4*)(ssq + (size_t)tok * 16);
    const f32x4 a = p[0], b = p[1], c = p[2], d = p[3];
    const float s = (((a[0] + a[1]) + (a[2] + a[3])) + ((b[0] + b[1]) + (b[2] + b[3]))) + (((c[0] + c[1]) + (c[2] + c[3])) + ((d[0] + d[1]) + (d[2] + d[3])));
    const float r = rinv_of(s);
#pragma unroll
    for (int bj = 0; bj < 2; ++bj)
#pragma unroll
        for (int q = 0; q < 8; ++q) rc[bj][q] = __shfl(r, (lane & 48) | (bj * 8 + q));
}
__device__ __forceinline__ void sincos_rev(float ang, float& sn, float& cs) { float rev = ang * INV2PI; rev = __builtin_amdgcn_fractf(rev); sn = __builtin_amdgcn_sinf(rev); cs = __builtin_amdgcn_cosf(rev); }

struct EpiQKV { static constexpr bool PERM = true; bf16_t* q; const float* ssq;
    __device__ __forceinline__ void operator()(const pg8::Acc& acc, const Unit& u, int wr, int wc, int fr, int fq) const {
        asm volatile("" : "+v"(fr), "+v"(fq));
        const int t = u.pn >> 2; bf16_t* base = q + (size_t)t * ((WS_K - WS_Q) / 2); const float sc = t == 0 ? C2 : 1.f;
        const int row0 = u.pm * 256 + wr * 64 + fr, col0 = (u.pn & 3) * 256 + wc * 32 + 8 * fq;
        float ri[2][4]; rinv_rows(ssq, row0, fq, ri);
#pragma unroll
        for (int ai = 0; ai < 2; ++ai)
#pragma unroll
            for (int m = 0; m < 4; ++m) { const float s = ri[ai][m] * sc; bf16_t* rowp = base + (size_t)(row0 + ai * 128 + m * 16) * D + col0;
#pragma unroll
                for (int bj = 0; bj < 2; ++bj) *(u32x4*)(rowp + bj * 128) = pack8(acc[ai][bj][m][0] * s, acc[ai][bj][m][1] * s); }
    }
};
struct EpiRes { static constexpr bool PERM = true; const float* base; float* out; bf16_t* hbf; float* ssq;
    __device__ __forceinline__ void operator()(const pg8::Acc& acc, const Unit& u, int wr, int wc, int fr, int fq) const {
        asm volatile("" : "+v"(fr), "+v"(fq));
        const int row0 = u.pm * 256 + wr * 64 + fr, col0 = u.pn * 256 + wc * 32 + 8 * fq;
#pragma unroll
        for (int ai = 0; ai < 2; ++ai)
#pragma unroll
            for (int m = 0; m < 4; ++m) { const int row = row0 + ai * 128 + m * 16; const size_t off = (size_t)row * D + col0; float ss = 0.f;
#pragma unroll
                for (int bj = 0; bj < 2; ++bj) { const f32x4 h0 = *(const f32x4*)(base + off + bj * 128) + acc[ai][bj][m][0], h1 = *(const f32x4*)(base + off + bj * 128 + 4) + acc[ai][bj][m][1];
                    *(f32x4*)(out + off + bj * 128) = h0; *(f32x4*)(out + off + bj * 128 + 4) = h1; *(u32x4*)(hbf + off + bj * 128) = pack8(h0, h1);
                    ss += ((h0[0] * h0[0] + h0[1] * h0[1]) + (h0[2] * h0[2] + h0[3] * h0[3])) + ((h1[0] * h1[0] + h1[1] * h1[1]) + (h1[2] * h1[2] + h1[3] * h1[3])); }
                ss += __shfl_xor(ss, 16); ss += __shfl_xor(ss, 32); if (fq == 0) ssq[(size_t)row * 16 + u.pn * 4 + wc] = ss;
                asm volatile("" ::: "memory"); }
    }
};
struct EpiUp { static constexpr bool PERM = true; bf16_t* uo; const float* ssq;
    __device__ __forceinline__ void operator()(const pg8::Acc& acc, const Unit& u, int wr, int wc, int fr, int fq) const {
        asm volatile("" : "+v"(fr), "+v"(fq));
        const int row0 = u.pm * 256 + wr * 64 + fr, col0 = u.pn * 256 + wc * 32 + 8 * fq;
        float ri[2][4]; rinv_rows(ssq, row0, fq, ri);
#pragma unroll
        for (int ai = 0; ai < 2; ++ai)
#pragma unroll
            for (int m = 0; m < 4; ++m) { const float s = ri[ai][m]; bf16_t* rowp = uo + (size_t)(row0 + ai * 128 + m * 16) * FF + col0;
#pragma unroll
                for (int bj = 0; bj < 2; ++bj) { f32x4 a = acc[ai][bj][m][0] * s, b = acc[ai][bj][m][1] * s;
#pragma unroll
                    for (int e = 0; e < 4; ++e) { const float x = fmaxf(a[e], 0.f), y = fmaxf(b[e], 0.f); a[e] = x * x; b[e] = y * y; }
                    *(u32x4*)(rowp + bj * 128) = pack8(a, b); } }
    }
};
struct EpiRetQK { static constexpr bool PERM = true; bf16_t* SQ; bf16_t* KN; const float* ssq;
    __device__ __forceinline__ void operator()(const pg8::Acc& acc, const Unit& u, int wr, int wc, int fr, int fq) const {
        asm volatile("" : "+v"(fr), "+v"(fq));
        const bool isq = u.pn < 4; const int h = u.pn & 3, b = u.pm >> 4, N = u.pm & 15, p = (b * 4 + h) * 16 + N;
        const int row0 = u.pm * 256 + wr * 64 + fr, i0 = wr * 64 + fr, cb = wc * 32 + 8 * fq; const float lg = lg2gamma(h);
        float ri[2][4]; rinv_rows(ssq, row0, fq, ri);
        float invf[8];
#pragma unroll
        for (int q = 0; q < 8; ++q) invf[q] = __builtin_amdgcn_exp2f(-(float)(cb + q) * L2B127);
#pragma unroll
        for (int ai = 0; ai < 2; ++ai)
#pragma unroll
            for (int m = 0; m < 4; ++m) { const int il = i0 + ai * 128 + m * 16; const float pos = (float)(N * 256 + il);
                const float s = ri[ai][m], sc = isq ? __builtin_amdgcn_exp2f(lg * (float)(il + 1)) : 0.0625f;
                f32x4 y1[2], y2[2];
#pragma unroll
                for (int n = 0; n < 2; ++n)
#pragma unroll
                    for (int e = 0; e < 4; ++e) { float sn, cs; sincos_rev(pos * invf[n * 4 + e], sn, cs); const float x1 = acc[ai][0][m][n][e] * s, x2 = acc[ai][1][m][n][e] * s;
                        y1[n][e] = (x1 * cs - x2 * sn) * sc; y2[n][e] = (x1 * sn + x2 * cs) * sc; }
                bf16_t* dst = isq ? SQ + (size_t)p * SQ_P + (size_t)il * 512 + 256 + cb : KN + (size_t)(row0 + ai * 128 + m * 16) * 1024 + h * 256 + cb;
                *(u32x4*)dst = pack8(y1[0], y1[1]); *(u32x4*)(dst + 128) = pack8(y2[0], y2[1]); __builtin_amdgcn_sched_barrier(0); }
    }
};
struct EpiRetKVt { static constexpr bool PERM = true; bf16_t* SQ; bf16_t* VS; const float* ssq;
    __device__ __forceinline__ void operator()(const pg8::Acc& acc, const Unit& u, int wr, int wc, int fr, int fq) const {
        asm volatile("" : "+v"(fr), "+v"(fq));
        const int lane = fq * 16 + fr; const int b = u.pn >> 4, N = u.pn & 15, jb = wc * 32 + 8 * fq;
        float rc[2][8]; rinv_cols(ssq, u.pn * 256 + jb, fr, lane, rc);
        if (u.pm < 4) { const int h = u.pm, p = (b * 4 + h) * 16 + N; const float lg = lg2gamma(h);
#pragma unroll
            for (int bj = 0; bj < 2; ++bj)
#pragma unroll
                for (int q = 0; q < 8; ++q) rc[bj][q] *= 0.0625f * __builtin_amdgcn_exp2f(lg * (float)(255 - (bj * 128 + jb + q)));
#pragma unroll
            for (int m = 0; m < 4; ++m) { const int d = wr * 64 + m * 16 + fr; const float invf = __builtin_amdgcn_exp2f(-(float)d * L2B127);
#pragma unroll
                for (int bj = 0; bj < 2; ++bj) { f32x4 y1[2], y2[2];
#pragma unroll
                    for (int n = 0; n < 2; ++n)
#pragma unroll
                        for (int e = 0; e < 4; ++e) { const float pos = (float)(N * 256 + bj * 128 + jb + n * 4 + e); float sn, cs; sincos_rev(pos * invf, sn, cs);
                            const float sc = rc[bj][n * 4 + e], x1 = acc[0][bj][m][n][e] * sc, x2 = acc[1][bj][m][n][e] * sc;
                            y1[n][e] = x1 * cs - x2 * sn; y2[n][e] = x1 * sn + x2 * cs; }
                    bf16_t* dst = SQ + (size_t)p * SQ_P + (size_t)d * 512 + bj * 128 + jb;
                    *(u32x4*)dst = pack8(y1[0], y1[1]); *(u32x4*)(dst + 128 * 512) = pack8(y2[0], y2[1]); __builtin_amdgcn_sched_barrier(0); } }
        } else { const int h = (u.pm - 4) >> 1, eh = (u.pm - 4) & 1, p = (b * 4 + h) * 16 + N;
#pragma unroll
            for (int ai = 0; ai < 2; ++ai)
#pragma unroll
                for (int m = 0; m < 4; ++m) { const int e_row = eh * 256 + ai * 128 + wr * 64 + m * 16 + fr;
#pragma unroll
                    for (int bj = 0; bj < 2; ++bj) { f32x4 a = acc[ai][bj][m][0], c = acc[ai][bj][m][1];
#pragma unroll
                        for (int e = 0; e < 4; ++e) { a[e] *= rc[bj][e]; c[e] *= rc[bj][4 + e]; }
                        *(u32x4*)(VS + (size_t)p * VS_P + (size_t)e_row * 512 + bj * 128 + jb) = pack8(a, c); } }
        }
    }
};
struct EpiKV { static constexpr bool PERM = true; bf16_t* VS;
    __device__ __forceinline__ void operator()(const pg8::Acc& acc, const Unit& u, int wr, int wc, int fr, int fq) const {
        asm volatile("" : "+v"(fr), "+v"(fq));
        bf16_t* base = VS + (size_t)u.p * VS_P + 256 + wc * 32 + 8 * fq;
#pragma unroll
        for (int ai = 0; ai < 2; ++ai)
#pragma unroll
            for (int m = 0; m < 4; ++m) { const int e_row = u.pm * 256 + ai * 128 + wr * 64 + m * 16 + fr;
#pragma unroll
                for (int bj = 0; bj < 2; ++bj) *(u32x4*)(base + (size_t)e_row * 512 + bj * 128) = pack8(acc[ai][bj][m][0], acc[ai][bj][m][1]); }
    }
};
struct EpiS { static constexpr bool PERM = true; bf16_t* SQ;
    __device__ __forceinline__ void operator()(const pg8::Acc& acc, const Unit& u, int wr, int wc, int fr, int fq) const {
        asm volatile("" : "+v"(fr), "+v"(fq));
        const int h = (u.p >> 4) & 3, jb = wc * 32 + 8 * fq; const float lg = lg2gamma(h);
        float gi[2][8];
#pragma unroll
        for (int bj = 0; bj < 2; ++bj)
#pragma unroll
            for (int q = 0; q < 8; ++q) gi[bj][q] = __builtin_amdgcn_exp2f(-lg * (float)(bj * 128 + jb + q + 1));
#pragma unroll
        for (int ai = 0; ai < 2; ++ai)
#pragma unroll
            for (int m = 0; m < 4; ++m) { const int i = ai * 128 + wr * 64 + m * 16 + fr;
#pragma unroll
                for (int bj = 0; bj < 2; ++bj) { f32x4 a = acc[ai][bj][m][0], c = acc[ai][bj][m][1];
#pragma unroll
                    for (int e = 0; e < 4; ++e) { const int d0 = i - (bj * 128 + jb + e);
                        a[e] = __uint_as_float(__float_as_uint(a[e] * gi[bj][e]) & ~(unsigned)(d0 >> 31)); c[e] = __uint_as_float(__float_as_uint(c[e] * gi[bj][4 + e]) & ~(unsigned)((d0 - 4) >> 31)); }
                    *(u32x4*)(SQ + (size_t)u.p * SQ_P + (size_t)i * 512 + bj * 128 + jb) = pack8(a, c); } __builtin_amdgcn_sched_barrier(0); }
    }
};
struct EpiO { static constexpr bool PERM = true; bf16_t* SQ; bf16_t* OH0; float* GN;
    __device__ __forceinline__ void operator()(const pg8::Acc& acc, const Unit& u, int wr, int wc, int fr, int fq) const {
        asm volatile("" : "+v"(fr), "+v"(fq));
        const int bh = u.p >> 4, N = u.p & 15, b = bh >> 2, h = bh & 3, cb = wc * 32 + 8 * fq;
        bf16_t* ob = u.pn == 0 ? OH0 + (size_t)u.p * 65536 : SQ + (size_t)u.p * SQ_P; const int pitch = u.pn == 0 ? 256 : 512;
#pragma unroll
        for (int ai = 0; ai < 2; ++ai)
#pragma unroll
            for (int m = 0; m < 4; ++m) { const int i = ai * 128 + wr * 64 + m * 16 + fr; float s = 0.f, q = 0.f;
#pragma unroll
                for (int bj = 0; bj < 2; ++bj) { const f32x4 a = acc[ai][bj][m][0], c = acc[ai][bj][m][1];
                    s += ((a[0] + a[1]) + (a[2] + a[3])) + ((c[0] + c[1]) + (c[2] + c[3]));
                    q += ((a[0] * a[0] + a[1] * a[1]) + (a[2] * a[2] + a[3] * a[3])) + ((c[0] * c[0] + c[1] * c[1]) + (c[2] * c[2] + c[3] * c[3]));
                    *(u32x4*)(ob + (size_t)i * pitch + bj * 128 + cb) = pack8(a, c); }
                s += __shfl_xor(s, 16); s += __shfl_xor(s, 32); q += __shfl_xor(q, 16); q += __shfl_xor(q, 32);
                if (fq == 0) { const size_t tok = (size_t)b * SEQ + N * 256 + i; *(f32x2*)(GN + (tok * 4 + h) * 16 + (u.pn * 4 + wc) * 2) = (f32x2){s, q}; } }
    }
};
struct EpiG { static constexpr bool PERM = true; const bf16_t* SQ; const bf16_t* OH0; const float* GN; const float* ssq; bf16_t* Y;
    __device__ __forceinline__ void operator()(const pg8::Acc& acc, const Unit& u, int wr, int wc, int fr, int fq) const {
        asm volatile("" : "+v"(fr), "+v"(fq));
        const int b = u.pm >> 4, N = u.pm & 15, h = u.pn >> 1, eh = u.pn & 1, p = (b * 4 + h) * 16 + N, cb = wc * 32 + 8 * fq;
        const int row0 = u.pm * 256 + wr * 64 + fr;
        float ri[2][4]; rinv_rows(ssq, row0, fq, ri);
        const bf16_t* ob = eh == 0 ? OH0 + (size_t)p * 65536 : SQ + (size_t)p * SQ_P; const int pitch = eh == 0 ? 256 : 512;
#pragma unroll
        for (int ai = 0; ai < 2; ++ai)
#pragma unroll
            for (int m = 0; m < 4; ++m) { const int i = ai * 128 + wr * 64 + m * 16 + fr; const size_t tok = (size_t)row0 + ai * 128 + m * 16;
                const f32x4 st = *(const f32x4*)(GN + (tok * 4 + h) * 16 + fq * 4); float s = st[0] + st[2], q = st[1] + st[3];
                s += __shfl_xor(s, 16); s += __shfl_xor(s, 32); q += __shfl_xor(q, 16); q += __shfl_xor(q, 32);
                const float mu = s * (1.0f / RDV), var = fmaxf(q * (1.0f / RDV) - mu * mu, 0.f), rstd = 1.0f / sqrtf(var + GN_EPS), rr = ri[ai][m];
#pragma unroll
                for (int bj = 0; bj < 2; ++bj) { const u32x4 ow = *(const u32x4*)(ob + (size_t)i * pitch + bj * 128 + cb); f32x4 a = acc[ai][bj][m][0] * rr, c = acc[ai][bj][m][1] * rr;
                    const float o8[8] = {bf_lo(ow.x), bf_hi(ow.x), bf_lo(ow.y), bf_hi(ow.y), bf_lo(ow.z), bf_hi(ow.z), bf_lo(ow.w), bf_hi(ow.w)};
#pragma unroll
                    for (int e = 0; e < 4; ++e) { const float g0 = a[e], g1 = c[e];
                        a[e] = g0 * __builtin_amdgcn_rcpf(1.f + __builtin_amdgcn_exp2f(-g0 * LOG2E)) * ((o8[e] - mu) * rstd);
                        c[e] = g1 * __builtin_amdgcn_rcpf(1.f + __builtin_amdgcn_exp2f(-g1 * LOG2E)) * ((o8[4 + e] - mu) * rstd); }
                    *(u32x4*)(Y + tok * 2048 + h * 512 + eh * 256 + bj * 128 + cb) = pack8(a, c); }
                asm volatile("" ::: "memory"); }
    }
};

struct KVOrder { int G, c; const char* VS; const char* SQ;
    __device__ __forceinline__ bool next(int i, Unit& u) const { const int p = c + (i >> 1) * G; if (p >= NPROB) return false; u.p = p; u.pm = i & 1; u.pn = 0;
        u.a = VS + (size_t)p * VS_P * 2 + (size_t)u.pm * 256 * 512 * 2; u.b = SQ + (size_t)p * SQ_P * 2; return true; } };
struct SOrder { int G, c; const char* SQ; const char* KN;
    __device__ __forceinline__ bool next(int i, Unit& u) const { const int p = c + i * G; if (p >= NPROB) return false; u.p = p; u.pm = 0; u.pn = 0;
        const int bh = p >> 4, N = p & 15, b = bh >> 2, h = bh & 3; u.a = SQ + (size_t)p * SQ_P * 2 + 512; u.b = KN + ((size_t)(b * SEQ + N * 256) * 1024 + h * 256) * 2; return true; } };
struct OOrder { int G, c; const char* SQ; const char* VS;
    __device__ __forceinline__ bool next(int i, Unit& u) const { const int p = c + (i >> 1) * G; if (p >= NPROB) return false; u.p = p; u.pm = 0; u.pn = i & 1;
        u.a = SQ + (size_t)p * SQ_P * 2; u.b = VS + (size_t)p * VS_P * 2 + (size_t)u.pn * 256 * 512 * 2; return true; } };

#define XB_TMO      128
#define XB_XCNT(j)  (256  + 64 * (j))
#define XB_XSUB(j)  (1280 + 64 * (j))
#define XB_XGEN(j)  (2304 + 64 * (j))
#define XB_TOP      3328
#define XB_TOPGEN   3392
#define XCD_BAR_WORDS 3456
#define XB_SPIN_CAP (1u << 18)
__device__ __forceinline__ unsigned xb_ld(unsigned* p)              { return __hip_atomic_load(p, __ATOMIC_RELAXED, __HIP_MEMORY_SCOPE_AGENT); }
__device__ __forceinline__ unsigned xb_add(unsigned* p, unsigned v) { return __hip_atomic_fetch_add(p, v, __ATOMIC_RELAXED, __HIP_MEMORY_SCOPE_AGENT); }
__device__ __forceinline__ unsigned xb_xcc_id() { return (unsigned)__builtin_amdgcn_s_getreg((3 << 11) | 20) & 0xFu; }
#define XB_SPIN(cond, bar) do { unsigned _sp = 0; while (cond) { __builtin_amdgcn_s_sleep(1); \
    if ((++_sp & 255u) == 0u) { if (xb_ld(&(bar)[XB_TMO])) break; if (_sp > XB_SPIN_CAP) { atomicAdd(&(bar)[XB_TMO], 1u); break; } } } } while (0)
struct XcdBarrier { unsigned* bar; unsigned x; volatile LAS unsigned* st; };
__device__ __forceinline__ XcdBarrier xcd_barrier_post(unsigned* bar, volatile LAS unsigned* st) {
    XcdBarrier b; b.bar = bar; b.x = xb_xcc_id(); b.st = st;
    if (threadIdx.x == 0) (void)xb_add(&bar[XB_XCNT(b.x)], 1u);
    return b;
}
__device__ __forceinline__ void xcd_barrier_complete(unsigned* bar, unsigned x, unsigned& nloc, unsigned& nx) {
    const unsigned G = gridDim.x * gridDim.y * gridDim.z;
    unsigned sum, cnt, mine, sp = 0u;
    for (;;) {
        sum = 0u; cnt = 0u; mine = 0u;
#pragma unroll
        for (unsigned j = 0; j < 16; ++j) { const unsigned c = xb_ld(&bar[XB_XCNT(j)]); sum += c; cnt += (c > 0u) ? 1u : 0u; mine = (j == x) ? c : mine; }
        if (sum == G) break;
        __builtin_amdgcn_s_sleep(1);
        if ((++sp & 255u) == 0u) { if (xb_ld(&bar[XB_TMO])) break; if (sp > XB_SPIN_CAP) { atomicAdd(&bar[XB_TMO], 1u); break; } }
    }
    nloc = mine > 0u ? mine : 1u; nx = cnt > 0u ? cnt : 1u;
}
__device__ __forceinline__ void xcd_barrier(const XcdBarrier& b) {
    asm volatile("s_waitcnt vmcnt(0)" ::: "memory");
    __syncthreads();
    if (threadIdx.x == 0) {
        unsigned* bar = b.bar;
        __builtin_amdgcn_s_waitcnt(0);
        unsigned nloc = b.st[0], nx = b.st[1];
        if (nloc == 0u) { xcd_barrier_complete(bar, b.x, nloc, nx); b.st[0] = nloc; b.st[1] = nx; }
        const unsigned old = xb_add(&bar[XB_XSUB(b.x)], 1u);
        const unsigned gen = old / nloc;
        if (old + 1u == (gen + 1u) * nloc) {
            __builtin_amdgcn_fence(__ATOMIC_RELEASE, "agent");
            asm volatile("s_waitcnt vmcnt(0)" ::: "memory");
            const unsigned og = xb_add(&bar[XB_TOP], 1u);
            const unsigned tg = og / nx;
            if (og + 1u == (tg + 1u) * nx) xb_add(&bar[XB_TOPGEN], 1u);
            else XB_SPIN(xb_ld(&bar[XB_TOPGEN]) == tg, bar);
            __builtin_amdgcn_fence(__ATOMIC_ACQUIRE, "agent");
            xb_add(&bar[XB_XGEN(b.x)], 1u);
            asm volatile("s_waitcnt vmcnt(0)" ::: "memory");
        } else {
            XB_SPIN(xb_ld(&bar[XB_XGEN(b.x)]) == gen, bar);
            __builtin_amdgcn_fence(__ATOMIC_ACQUIRE, "agent");
            asm volatile("s_waitcnt vmcnt(0)" ::: "memory");
        }
    }
    __syncthreads();
}

__device__ __forceinline__ void transpose_item(const float* W, const float* g, int K, int N, bf16_t* WT, LAS float* scr, int item, int lane) {
    const int nblk = N / 32, kb = item / nblk, nb = item % nblk, k0 = 64 * kb, n0 = 32 * nb;
#pragma unroll 8
    for (int i = 0; i < 32; ++i) { const int kk = 2 * i + (lane >> 5); const float gv = g ? g[k0 + kk] : 1.f; scr[kk * 33 + (lane & 31)] = W[(size_t)(k0 + kk) * N + n0 + (lane & 31)] * gv; }
    LDS_WAIT(); asm volatile("" ::: "memory");
    const int c = lane & 7;
#pragma unroll
    for (int j = 0; j < 4; ++j) { const int n = (lane >> 3) + 8 * j; const LAS float* s = scr + (8 * c) * 33 + n;
        u32x4 o; o.x = cvt_pk_bf16(s[0 * 33], s[1 * 33]); o.y = cvt_pk_bf16(s[2 * 33], s[3 * 33]); o.z = cvt_pk_bf16(s[4 * 33], s[5 * 33]); o.w = cvt_pk_bf16(s[6 * 33], s[7 * 33]);
        *(u32x4*)(WT + (size_t)(n0 + n) * K + k0 + 8 * c) = o; }
    LDS_WAIT(); asm volatile("" ::: "memory");
}
__device__ __forceinline__ void convert_pair(const float* W0, const float* g0, int K0, int N0, bf16_t* T0, const float* W1, const float* g1, int K1, int N1, bf16_t* T1, LAS unsigned char* lds, int gw, int ngw, int wave, int lane) {
    LAS float* scr = (LAS float*)(lds + wave * 16384);
    const int I0 = (K0 / 64) * (N0 / 32), I1 = (K1 / 64) * (N1 / 32);
    for (int it = gw; it < I0 + I1; it += ngw) { if (it < I0) transpose_item(W0, g0, K0, N0, T0, scr, it, lane); else transpose_item(W1, g1, K1, N1, T1, scr, it - I0, lane); }
    __syncthreads();
}
__device__ __forceinline__ void convert_mix(int L, const float* const* in, unsigned char* ws, LAS unsigned char* lds, int gw, int ngw, int wave, int lane) {
    const int i = L >> 1; const float* g = in[5] + (size_t)L * D; bf16_t* T = (bf16_t*)(ws + WS_WMIX);
    if ((L & 1) == 0) convert_pair(in[1] + (size_t)i * D * 3 * D, g, D, 3 * D, T, in[2] + (size_t)i * D * D, nullptr, D, D, T + (size_t)3 * D * D, lds, gw, ngw, wave, lane);
    else convert_pair(in[3] + (size_t)i * D * 6 * D, g, D, 6 * D, T, in[4] + (size_t)i * 2 * D * D, nullptr, 2 * D, D, T + (size_t)6 * D * D, lds, gw, ngw, wave, lane);
}
__device__ __forceinline__ void convert_mlp(int L, const float* const* in, unsigned char* ws, LAS unsigned char* lds, int gw, int ngw, int wave, int lane) {
    bf16_t* T = (bf16_t*)(ws + WS_WMLP);
    convert_pair(in[7] + (size_t)L * D * FF, in[6] + (size_t)L * D, D, FF, T, in[8] + (size_t)L * FF * D, nullptr, FF, D, T + (size_t)FF * D, lds, gw, ngw, wave, lane);
}
__device__ __forceinline__ void p0_rows(const float* x, bf16_t* hbf, float* ssq, int gw, int ngw, int lane) {
    for (int m = gw; m < M; m += ngw) { const f32x4* xr = (const f32x4*)(x + (size_t)m * D) + lane; f32x4 v[4]; float s = 0.f;
#pragma unroll
        for (int j = 0; j < 4; ++j) { v[j] = xr[64 * j]; s += (v[j][0] * v[j][0] + v[j][1] * v[j][1]) + (v[j][2] * v[j][2] + v[j][3] * v[j][3]); }
        s = wave_sum(s);
        u32x2* o8 = (u32x2*)(hbf + (size_t)m * D) + lane;
#pragma unroll
        for (int j = 0; j < 4; ++j) { u32x2 w; w.x = cvt_pk_bf16(v[j][0], v[j][1]); w.y = cvt_pk_bf16(v[j][2], v[j][3]); o8[64 * j] = w; }
        if (lane < 16) ssq[(size_t)m * 16 + lane] = lane == 0 ? s : 0.f; }
}
__device__ __forceinline__ void final_rows(float* out, const float* ssq, const float* gf, int gw, int ngw, int lane) {
    for (int m = gw; m < M; m += ngw) { float s = ssq[(size_t)m * 16 + (lane & 15)]; s += __shfl_xor(s, 1); s += __shfl_xor(s, 2); s += __shfl_xor(s, 4); s += __shfl_xor(s, 8);
        const float r = rinv_of(s); f32x4* xr = (f32x4*)(out + (size_t)m * D) + lane; const f32x4* gr = (const f32x4*)gf + lane;
#pragma unroll
        for (int j = 0; j < 4; ++j) xr[64 * j] = xr[64 * j] * r * gr[64 * j]; }
}
__device__ __forceinline__ void ret_scan(bf16_t* VS, int gtid, int gthreads) {
    for (int g = gtid; g < BATCH * RH * RDV * 32; g += gthreads) { const int bh = g >> 14, rem = g & 16383, e = rem >> 5, dg = rem & 31, h = bh & 3;
        const float dec = __builtin_amdgcn_exp2f(256.f * lg2gamma(h));
        bf16_t* p = VS + (size_t)bh * 16 * VS_P + (size_t)e * 512 + 256 + dg * 8; float st[8];
#pragma unroll
        for (int k = 0; k < 8; ++k) st[k] = 0.f;
        u32x4 w[16];
#pragma unroll
        for (int N = 0; N < 16; ++N) w[N] = *(const u32x4*)(p + (size_t)N * VS_P);
#pragma unroll
        for (int N = 0; N < 16; ++N) { u32x4 o; o.x = cvt_pk_bf16(st[0], st[1]); o.y = cvt_pk_bf16(st[2], st[3]); o.z = cvt_pk_bf16(st[4], st[5]); o.w = cvt_pk_bf16(st[6], st[7]);
            *(u32x4*)(p + (size_t)N * VS_P) = o;
            st[0] = dec * st[0] + bf_lo(w[N].x); st[1] = dec * st[1] + bf_hi(w[N].x); st[2] = dec * st[2] + bf_lo(w[N].y); st[3] = dec * st[3] + bf_hi(w[N].y);
            st[4] = dec * st[4] + bf_lo(w[N].z); st[5] = dec * st[5] + bf_hi(w[N].z); st[6] = dec * st[6] + bf_lo(w[N].w); st[7] = dec * st[7] + bf_hi(w[N].w); } }
}
__device__ __forceinline__ void sb_attn_simple(const bf16_t* Q, const bf16_t* K, const bf16_t* V, bf16_t* O, int gw, int ngw, int lane) {
    for (int task = gw; task < BATCH * SBH * (SEQ / 64); task += ngw) {
        const int bh = task >> 6, qb = task & 63, b = bh >> 4, h = bh & 15, q0 = qb * 64, t = q0 + lane;
        const size_t rowoff = ((size_t)b * SEQ + t) * D + h * SBD;
        float q[64], o[64];
#pragma unroll
        for (int i = 0; i < 8; ++i) { const u32x4 w = *(const u32x4*)(Q + rowoff + i * 8); q[8 * i + 0] = bf_lo(w.x); q[8 * i + 1] = bf_hi(w.x); q[8 * i + 2] = bf_lo(w.y); q[8 * i + 3] = bf_hi(w.y);
            q[8 * i + 4] = bf_lo(w.z); q[8 * i + 5] = bf_hi(w.z); q[8 * i + 6] = bf_lo(w.w); q[8 * i + 7] = bf_hi(w.w); }
#pragma unroll
        for (int i = 0; i < 64; ++i) o[i] = 0.f;
        float carry = 0.f;
        const bf16_t* Kb = K + (size_t)b * SEQ * D + h * SBD; const bf16_t* Vb = V + (size_t)b * SEQ * D + h * SBD;
        for (int s = q0 + 62; s >= 0; --s) {
            const u32x4* kr = (const u32x4*)(Kb + (size_t)s * D); float z0 = 0.f, z1 = 0.f;
#pragma unroll
            for (int i = 0; i < 8; ++i) { const u32x4 w = kr[i];
                z0 += q[8 * i + 0] * bf_lo(w.x); z1 += q[8 * i + 1] * bf_hi(w.x); z0 += q[8 * i + 2] * bf_lo(w.y); z1 += q[8 * i + 3] * bf_hi(w.y);
                z0 += q[8 * i + 4] * bf_lo(w.z); z1 += q[8 * i + 5] * bf_hi(w.z); z0 += q[8 * i + 6] * bf_lo(w.w); z1 += q[8 * i + 7] * bf_hi(w.w); }
            const float z = z0 + z1;
            const float l = __builtin_amdgcn_logf(1.f + __builtin_amdgcn_exp2f(-fabsf(z)));
            const float lk = -(fmaxf(z, 0.f) + l);
            const bool valid = s < t;
            const float a = valid ? __builtin_amdgcn_exp2f((z + lk) + carry) : 0.f;
            carry += valid ? lk : 0.f;
            const u32x4* vr = (const u32x4*)(Vb + (size_t)s * D);
#pragma unroll
            for (int i = 0; i < 8; ++i) { const u32x4 w = vr[i];
                o[8 * i + 0] += a * bf_lo(w.x); o[8 * i + 1] += a * bf_hi(w.x); o[8 * i + 2] += a * bf_lo(w.y); o[8 * i + 3] += a * bf_hi(w.y);
                o[8 * i + 4] += a * bf_lo(w.z); o[8 * i + 5] += a * bf_hi(w.z); o[8 * i + 6] += a * bf_lo(w.w); o[8 * i + 7] += a * bf_hi(w.w); }
            if (__all(carry < -152.f)) break;
        }
#pragma unroll
        for (int i = 0; i < 8; ++i) { u32x4 w; w.x = cvt_pk_bf16(o[8 * i + 0], o[8 * i + 1]); w.y = cvt_pk_bf16(o[8 * i + 2], o[8 * i + 3]); w.z = cvt_pk_bf16(o[8 * i + 4], o[8 * i + 5]); w.w = cvt_pk_bf16(o[8 * i + 6], o[8 * i + 7]);
            *(u32x4*)(O + rowoff + i * 8) = w; }
    }
}


typedef float f32x16 __attribute__((ext_vector_type(16)));
typedef short v4i16_t __attribute__((ext_vector_type(4)));
__device__ __forceinline__ v4i16_t vtr(const LAS unsigned char* p) { return __builtin_amdgcn_ds_read_tr16_b64_v4i16((LAS v4i16_t*)p); }
__device__ __forceinline__ float lane_partner(float mine) {
    const unsigned m = __float_as_uint(mine); const auto rr = __builtin_amdgcn_permlane32_swap(m, m, false, false); return __uint_as_float(rr[0] ^ rr[1] ^ m);
}
template <bool DIAG> __device__ __forceinline__ void sb_tile_math(float (&zz)[32], float& carry, int qlim, int hi, float m0) {
    float lk[32];
#pragma unroll
    for (int n = 0; n < 32; ++n) { const float z = zz[n];
        const float l = __builtin_amdgcn_logf(1.f + __builtin_amdgcn_exp2f(-fabsf(z)));
        float k = -(fmaxf(z, 0.f) + l), s = z + k;
        if (DIAG) { const bool v = ((n & 3) + 8 * ((n & 15) >> 2) + 32 * (n >> 4)) < qlim; k = v ? k : 0.f; s = v ? s : -INFINITY; }
        lk[n] = k; zz[n] = s; }
    float W = 0.f, off[8];
#pragma unroll
    for (int i = 7; i >= 0; --i) { const float t = ((lk[4 * i + 3] + lk[4 * i + 2]) + lk[4 * i + 1]) + lk[4 * i]; const float other = lane_partner(t); off[i] = carry + (W + m0 * other); W += t + other; }
    carry += W;
#pragma unroll
    for (int i = 0; i < 8; ++i) { const float bs = off[i], a = lk[4 * i + 3], b = a + lk[4 * i + 2], c = b + lk[4 * i + 1];
        zz[4 * i + 3] = __builtin_amdgcn_exp2f(zz[4 * i + 3] + bs); zz[4 * i + 2] = __builtin_amdgcn_exp2f(zz[4 * i + 2] + (bs + a));
        zz[4 * i + 1] = __builtin_amdgcn_exp2f(zz[4 * i + 1] + (bs + b)); zz[4 * i] = __builtin_amdgcn_exp2f(zz[4 * i] + (bs + c)); }
}
__device__ __forceinline__ void sb_load_tile(bf16x8 (&kf)[8], u32x4 (&vv)[8], const bf16_t* Kh, const bf16_t* Vh, int j, int lane) {
    const int r32 = lane & 31, hi = lane >> 5;
    const bf16_t* kp = Kh + (size_t)(64 * j + r32) * D + 8 * hi;
#pragma unroll
    for (int d0 = 0; d0 < 4; ++d0) { kf[2 * d0] = *(const bf16x8*)(kp + 16 * d0); kf[2 * d0 + 1] = *(const bf16x8*)(kp + (size_t)32 * D + 16 * d0); }
    const bf16_t* vp = Vh + (size_t)(64 * j + (lane >> 2)) * D + (lane & 3) * 8;
#pragma unroll
    for (int w = 0; w < 8; ++w) vv[w] = *(const u32x4*)(vp + (size_t)(16 * (w & 3)) * D + (w >> 2) * 32);
}
template <bool DIAG> __device__ __forceinline__ void sb_tile(const bf16x8 (&kf)[8], const bf16x8 (&qr)[4], const LAS unsigned char* vp0, f32x16& o0, f32x16& o1, float& carry, int qlim, int hi, float m0) {
    f32x16 p0 = {0.f, 0.f, 0.f, 0.f, 0.f, 0.f, 0.f, 0.f, 0.f, 0.f, 0.f, 0.f, 0.f, 0.f, 0.f, 0.f}, p1 = p0;
#pragma unroll
    for (int d0 = 0; d0 < 4; ++d0) { p0 = __builtin_amdgcn_mfma_f32_32x32x16_bf16(kf[2 * d0], qr[d0], p0, 0, 0, 0); p1 = __builtin_amdgcn_mfma_f32_32x32x16_bf16(kf[2 * d0 + 1], qr[d0], p1, 0, 0, 0); }
    float zz[32];
#pragma unroll
    for (int r = 0; r < 16; ++r) { zz[r] = p0[r]; zz[16 + r] = p1[r]; }
    sb_tile_math<DIAG>(zz, carry, qlim, hi, m0);
    u32x4 pw[4];
#pragma unroll
    for (int k = 0; k < 4; ++k) { pw[k].x = cvt_pk_bf16(zz[8 * k + 0], zz[8 * k + 1]); pw[k].y = cvt_pk_bf16(zz[8 * k + 2], zz[8 * k + 3]); pw[k].z = cvt_pk_bf16(zz[8 * k + 4], zz[8 * k + 5]); pw[k].w = cvt_pk_bf16(zz[8 * k + 6], zz[8 * k + 7]); }
#pragma unroll
    for (int d0 = 0; d0 < 2; ++d0)
#pragma unroll
        for (int ks = 0; ks < 4; ++ks) { const v4i16_t lo = vtr(vp0 + d0 * 4096 + ks * 1024), hh = vtr(vp0 + d0 * 4096 + ks * 1024 + 512);
            const bf16x8 vf = (bf16x8){lo[0], lo[1], lo[2], lo[3], hh[0], hh[1], hh[2], hh[3]};
            if (d0 == 0) o0 = __builtin_amdgcn_mfma_f32_32x32x16_bf16(__builtin_bit_cast(bf16x8, pw[ks]), vf, o0, 0, 0, 0);
            else o1 = __builtin_amdgcn_mfma_f32_32x32x16_bf16(__builtin_bit_cast(bf16x8, pw[ks]), vf, o1, 0, 0, 0); }
}
__device__ __forceinline__ void sb_attn_mfma(const bf16_t* Q, const bf16_t* K, const bf16_t* V, bf16_t* O, LAS unsigned char* lds, int gw, int ngw, int wave, int lane_in) {
    LAS unsigned char* vb = lds + wave * 8192;
    for (int unit = gw; unit < BATCH * SBH * (SEQ / 32); unit += ngw) {
        int lane = lane_in; asm volatile("" : "+v"(lane));
        const int r32 = lane & 31, hi = lane >> 5; const float m0 = hi == 0 ? 1.f : 0.f;
        const LAS unsigned char* vp0 = vb + ((lane >> 4) & 1) * 32 + (lane & 3) * 8 + (4 * hi + ((lane & 15) >> 2)) * 64;
        LAS unsigned char* vw = vb + lane * 16;
        const int bh = unit >> 7, qb = unit & 127, b = bh >> 4, h = bh & 15, qs = qb * 32, jd = qs >> 6;
        const bf16_t* Qw = Q + ((size_t)b * SEQ + qs + r32) * D + h * SBD + hi * 8;
        bf16x8 qr[4];
#pragma unroll
        for (int d0 = 0; d0 < 4; ++d0) qr[d0] = *(const bf16x8*)(Qw + d0 * 16);
        const bf16_t* Kh = K + (size_t)b * SEQ * D + h * SBD; const bf16_t* Vh = V + (size_t)b * SEQ * D + h * SBD;
        bf16x8 kc[8], kn[8]; u32x4 vn[8];
        int j = jd;
        sb_load_tile(kc, vn, Kh, Vh, j, lane);
#pragma unroll
        for (int w = 0; w < 8; ++w) *(LAS u32x4*)(vw + w * 1024) = vn[w];
        f32x16 o0 = {0.f, 0.f, 0.f, 0.f, 0.f, 0.f, 0.f, 0.f, 0.f, 0.f, 0.f, 0.f, 0.f, 0.f, 0.f, 0.f}, o1 = o0; float carry = 0.f;
        if (j > 0) sb_load_tile(kn, vn, Kh, Vh, j - 1, lane);
        sb_tile<true>(kc, qr, vp0, o0, o1, carry, (qs & 63) + r32 - 4 * hi, hi, m0);
        while (j > 0 && !__all(carry < -152.f)) {
#pragma unroll
            for (int w = 0; w < 8; ++w) *(LAS u32x4*)(vw + w * 1024) = vn[w];
#pragma unroll
            for (int i = 0; i < 8; ++i) kc[i] = kn[i];
            --j;
            if (j > 0) sb_load_tile(kn, vn, Kh, Vh, j - 1, lane);
            sb_tile<false>(kc, qr, vp0, o0, o1, carry, 0, hi, m0);
        }
        bf16_t* Ow = O + ((size_t)b * SEQ + qs + 4 * hi) * D + h * SBD + r32;
#pragma unroll
        for (int r = 0; r < 16; ++r) { const int q = (r & 3) + 8 * (r >> 2); const unsigned w0 = cvt_pk_bf16(o0[r], o1[r]);
            Ow[(size_t)q * D] = (bf16_t)(w0 & 0xffffu); Ow[(size_t)q * D + 32] = (bf16_t)(w0 >> 16); }
    }
}

#ifndef PROBE_SEL
#define PROBE_SEL -1
#endif
struct Probe { unsigned long long last, sel, tb; };
#if PROBE_SEL >= 0
#define PH_END(k) do { const unsigned long long now_ = __builtin_amdgcn_s_memrealtime(); if ((k) == PROBE_SEL) pr.sel += now_ - pr.last; pr.last = now_; } while (0)
#define GRID_BAR() do { pr.tb = __builtin_amdgcn_s_memrealtime(); xcd_barrier(bar); if (PROBE_SEL == 13) pr.sel += __builtin_amdgcn_s_memrealtime() - pr.tb; } while (0)
#else
#define PH_END(k) do { } while (0)
#define GRID_BAR() xcd_barrier(bar)
#endif
struct Args { const float* in[10]; float* out; unsigned char* ws; };
struct Ctx { LAS unsigned char* lds; unsigned char* ws; const float* const* in; float* out; int G, bx, gw, ngw, wave, lane, tid; };

template <int L> __device__ __forceinline__ void layer(const Ctx& c, const XcdBarrier& bar, Probe& pr) {
    LAS unsigned char* lds = c.lds; unsigned char* ws = c.ws; const int G = c.G, bx = c.bx;
    const float* x = c.in[0]; float* out = c.out;
    float* ssq = (float*)(ws + WS_SSQ); float* GN = (float*)(ws + WS_GN);
    bf16_t* hbf = (bf16_t*)(ws + WS_HBF); bf16_t* wmix = (bf16_t*)(ws + WS_WMIX); bf16_t* wmlp = (bf16_t*)(ws + WS_WMLP);
    const float* base = (L == 0) ? x : out;
    if constexpr ((L & 1) == 0) {
        bf16_t* Qb = (bf16_t*)(ws + WS_Q); bf16_t* Kb = (bf16_t*)(ws + WS_K); bf16_t* Vb = (bf16_t*)(ws + WS_V);
        { pg8::StdOrder S; S.init(M, 3 * D, G, bx, hbf, wmix, D, D); EpiQKV E{Qb, ssq};
          pg8::gemm_phase<EpiQKV, pg8::StdOrder, D, D, D, true>(lds, S, E); }
        GRID_BAR(); PH_END(1);
        sb_attn_mfma(Qb, Kb, Vb, Qb, lds, c.gw, c.ngw, c.wave, c.lane);
        GRID_BAR(); PH_END(2);
        convert_mlp(L, c.in, ws, lds, c.gw, c.ngw, c.wave, c.lane);
        { pg8::StdOrder S; S.init(M, D, G, bx, Qb, wmix + (size_t)3 * D * D, D, D); EpiRes E{base, out, hbf, ssq};
          pg8::gemm_phase<EpiRes, pg8::StdOrder, D, D, D, false>(lds, S, E); }
        GRID_BAR(); PH_END(3);
    } else {
        bf16_t* SQ = (bf16_t*)(ws + WS_SQ); bf16_t* VS = (bf16_t*)(ws + WS_VS); bf16_t* KN = (bf16_t*)(ws + WS_KN); bf16_t* Y = (bf16_t*)(ws + WS_Y);
        { pg8::StdOrder S; S.init(M, 2 * D, G, bx, hbf, wmix, D, D); EpiRetQK E{SQ, KN, ssq};
          pg8::gemm_phase<EpiRetQK, pg8::StdOrder, D, D, D, true>(lds, S, E); }
        { pg8::StdOrder S; S.init(3 * D, M, G, bx, wmix + (size_t)D * D, hbf, D, D); EpiRetKVt E{SQ, VS, ssq};
          pg8::gemm_phase<EpiRetKVt, pg8::StdOrder, D, D, D, true>(lds, S, E); }
        GRID_BAR(); PH_END(4);
        { KVOrder S{G, bx, (const char*)VS, (const char*)SQ}; EpiKV E{VS};
          pg8::gemm_phase<EpiKV, KVOrder, 512, 512, 256, true>(lds, S, E); }
        { SOrder S{G, bx, (const char*)SQ, (const char*)KN}; EpiS E{SQ};
          pg8::gemm_phase<EpiS, SOrder, 512, 1024, 256, true>(lds, S, E); }
        GRID_BAR(); PH_END(5);
        ret_scan(VS, bx * NWAVES * 64 + c.tid, G * NWAVES * 64);
        GRID_BAR(); PH_END(6);
        { OOrder S{G, bx, (const char*)SQ, (const char*)VS}; EpiO E{SQ, KN, GN};
          pg8::gemm_phase<EpiO, OOrder, 512, 512, 512, true>(lds, S, E); }
        GRID_BAR(); PH_END(7);
        { pg8::StdOrder S; S.init(M, 2 * D, G, bx, hbf, wmix + (size_t)4 * D * D, D, D); EpiG E{SQ, KN, GN, ssq, Y};
          pg8::gemm_phase<EpiG, pg8::StdOrder, D, D, D, true>(lds, S, E); }
        GRID_BAR(); PH_END(8);
        convert_mlp(L, c.in, ws, lds, c.gw, c.ngw, c.wave, c.lane);
        { pg8::StdOrder S; S.init(M, D, G, bx, Y, wmix + (size_t)6 * D * D, 2 * D, 2 * D); EpiRes E{base, out, hbf, ssq};
          pg8::gemm_phase<EpiRes, pg8::StdOrder, 2 * D, 2 * D, 2 * D, false>(lds, S, E); }
        GRID_BAR(); PH_END(9);
    }
    bf16_t* U = (bf16_t*)(ws + WS_U);
    { pg8::StdOrder S; S.init(M, FF, G, bx, hbf, wmlp, D, D); EpiUp E{U, ssq};
      pg8::gemm_phase<EpiUp, pg8::StdOrder, D, D, D, true>(lds, S, E); }
    GRID_BAR(); PH_END(10);
    if constexpr (L + 1 < NLAYER) convert_mix(L + 1, c.in, ws, lds, c.gw, c.ngw, c.wave, c.lane);
    { pg8::StdOrder S; S.init(M, D, G, bx, U, wmlp + (size_t)FF * D, FF, FF); EpiRes E{out, out, hbf, ssq};
      pg8::gemm_phase<EpiRes, pg8::StdOrder, FF, FF, FF, false>(lds, S, E); }
    GRID_BAR(); PH_END(11);
}

__global__ void __launch_bounds__(NWAVES * 64, 2) trunk_fwd(Args args) {
    extern __shared__ __attribute__((aligned(16))) unsigned char lds_raw[];
    LAS unsigned char* lds = (LAS unsigned char*)lds_raw;
    volatile LAS unsigned* MISC = (volatile LAS unsigned*)(lds + MISC_OFF);
    const int tid = threadIdx.x, lane = tid & 63, wave = __builtin_amdgcn_readfirstlane(tid >> 6);
    const int G = gridDim.x, bx = blockIdx.x;
    const int gw = bx * NWAVES + wave, ngw = G * NWAVES;
    unsigned char* ws = args.ws;
    unsigned* ctl = (unsigned*)(ws + WS_CTL);
    for (int u = tid; u < (LDS_BYTES - LDSCTL_OFF) / 4; u += NWAVES * 64) ((LAS unsigned*)(lds + LDSCTL_OFF))[u] = 0u;
    __syncthreads();
    const XcdBarrier bar = xcd_barrier_post(ctl + 4096, MISC + 8);
    const Ctx c{lds, ws, args.in, args.out, G, bx, gw, ngw, wave, lane, tid};
    Probe pr{0ull, 0ull, 0ull};
#if PROBE_SEL >= 0
    pr.last = __builtin_amdgcn_s_memrealtime();
#endif

    p0_rows(args.in[0], (bf16_t*)(ws + WS_HBF), (float*)(ws + WS_SSQ), gw, ngw, lane);
    convert_mix(0, args.in, ws, lds, gw, ngw, wave, lane);
    GRID_BAR(); PH_END(0);
    layer<0>(c, bar, pr); layer<1>(c, bar, pr); layer<2>(c, bar, pr); layer<3>(c, bar, pr);
    { int lane_f = lane; asm volatile("" : "+v"(lane_f));
      final_rows(args.out, (const float*)(ws + WS_SSQ), args.in[9], gw, ngw, lane_f); }
#if PROBE_SEL >= 0
    PH_END(12);
    if (bx == 0 && tid == 0) { const unsigned long long t0 = __builtin_amdgcn_s_memrealtime(); while (__builtin_amdgcn_s_memrealtime() - t0 < 8ull * pr.sel) __builtin_amdgcn_s_sleep(8); }
#endif
}

extern "C" void kernel_launch(void* const* d_in, const int* in_sizes, int n_in, void* d_out, int out_size, void* d_ws, size_t ws_size, hipStream_t stream) {
    static int grid = 0;
    if (grid == 0) {
        if (n_in != 10 || in_sizes[0] != M * D || out_size != M * D || ws_size < WS_END) { fprintf(stderr, "kernel_launch: unexpected shapes / workspace (%d inputs, ws %zu < %zu)\n", n_in, ws_size, (size_t)WS_END); grid = -1; return; }
        int dev = 0, cus = 0, per_cu = 0;
        if (hipGetDevice(&dev) != hipSuccess || hipDeviceGetAttribute(&cus, hipDeviceAttributeMultiprocessorCount, dev) != hipSuccess) { grid = -1; return; }
        if (hipFuncSetAttribute((const void*)trunk_fwd, hipFuncAttributeMaxDynamicSharedMemorySize, LDS_BYTES) != hipSuccess) { fprintf(stderr, "kernel_launch: hipFuncSetAttribute failed\n"); grid = -1; return; }
        if (hipOccupancyMaxActiveBlocksPerMultiprocessor(&per_cu, (const void*)trunk_fwd, NWAVES * 64, LDS_BYTES) != hipSuccess || per_cu < 1) fprintf(stderr, "kernel_launch: occupancy query reports %d\n", per_cu);
        (void)hipGetLastError();
        grid = cus;
    }
    if (grid < 0) return;
    if (hipMemsetAsync((char*)d_ws + WS_CTL, 0, CTL_ZERO_BYTES, stream) != hipSuccess) return;
    Args a{};
    for (int i = 0; i < 10; ++i) a.in[i] = (const float*)d_in[i];
    a.out = (float*)d_out; a.ws = (unsigned char*)d_ws;
    hipLaunchKernelGGL(trunk_fwd, dim3(grid), dim3(NWAVES * 64), LDS_BYTES, stream, a);
}
```

```cpp
#include <hip/hip_runtime.h>
#include <cstdio>
#include <cstdint>

#define PG8_LAS __attribute__((address_space(3)))
#define GAS __attribute__((address_space(1)))
#define LAS __attribute__((address_space(3)))
typedef unsigned short bf16_t;
typedef short bf16x8 __attribute__((ext_vector_type(8)));
typedef float f32x4 __attribute__((ext_vector_type(4)));
typedef float f32x2 __attribute__((ext_vector_type(2)));
typedef unsigned u32x4 __attribute__((ext_vector_type(4)));
typedef unsigned u32x2 __attribute__((ext_vector_type(2)));

constexpr int BATCH = 4, SEQ = 4096, D = 1024, FF = 4096, NLAYER = 4;
constexpr int M = BATCH * SEQ;
constexpr int SBH = 16, SBD = 64;
constexpr int RH = 4, RDK = 256, RDV = 512, RC = 256, RNC = SEQ / RC;
constexpr int NPROB = BATCH * RH * RNC;
constexpr float RMS_EPS = 1e-6f, GN_EPS = 1e-6f;
constexpr float C2 = 0.18033688011112042f;
constexpr float L2B127 = 0.10462765653188542f;
constexpr float INV2PI = 0.15915494309189535f;
constexpr float LOG2E = 1.4426950408889634f;
__device__ __forceinline__ float lg2gamma(int h) { return h == 0 ? -0.04580368961312479f : (h == 1 ? -0.02272007650008353f : (h == 2 ? -0.011315313227834146f : -0.005646563141142063f)); }

constexpr size_t MiB = 1u << 20;
constexpr size_t WS_CTL = 0, CTL_ZERO_BYTES = 1 * MiB;
constexpr size_t WS_SSQ = 1 * MiB;
constexpr size_t WS_GN = 2 * MiB;
constexpr size_t WS_HBF = 6 * MiB;
constexpr size_t WS_WMIX = 38 * MiB;
constexpr size_t WS_SCR = 54 * MiB;
constexpr size_t WS_Q = WS_SCR, WS_K = WS_SCR + 32 * MiB, WS_V = WS_SCR + 64 * MiB;
constexpr size_t WS_SQ = WS_SCR;
constexpr size_t WS_VS = WS_SCR + 64 * MiB;
constexpr size_t WS_KN = WS_SCR + 192 * MiB;
constexpr size_t WS_Y = WS_VS;
constexpr size_t WS_U = WS_SCR;
constexpr size_t WS_WMLP = WS_SCR + 192 * MiB;
constexpr size_t WS_END = WS_SCR + 224 * MiB;
constexpr size_t SQ_P = 256 * 512, VS_P = 512 * 512;

constexpr int RING_BYTES = 131072, LDSCTL_OFF = RING_BYTES, MISC_OFF = LDSCTL_OFF + 320, LDS_BYTES = 147456;
constexpr int NWAVES = 8;

__device__ __forceinline__ unsigned cvt_pk_bf16(float lo, float hi) { unsigned r; asm volatile("v_cvt_pk_bf16_f32 %0, %1, %2" : "=v"(r) : "v"(lo), "v"(hi)); return r; }
__device__ __forceinline__ float bf_lo(unsigned w) { return __uint_as_float(w << 16); }
__device__ __forceinline__ float bf_hi(unsigned w) { return __uint_as_float(w & 0xffff0000u); }
__device__ __forceinline__ u32x4 pack8(f32x4 a, f32x4 b) { u32x4 w; w.x = cvt_pk_bf16(a[0], a[1]); w.y = cvt_pk_bf16(a[2], a[3]); w.z = cvt_pk_bf16(b[0], b[1]); w.w = cvt_pk_bf16(b[2], b[3]); return w; }
__device__ __forceinline__ float wave_sum(float v) {
#pragma unroll
    for (int o = 1; o < 64; o <<= 1) v += __shfl_xor(v, o);
    return v;
}
__device__ __forceinline__ float rinv_of(float ss) { return 1.0f / sqrtf(ss * (1.0f / D) + RMS_EPS); }
#define LDS_WAIT() asm volatile("s_waitcnt lgkmcnt(0)" ::: "memory")
#define VM_WAIT() asm volatile("s_waitcnt vmcnt(0)" ::: "memory")

namespace pg8 {
constexpr int BM = 256, BK = 64, HALF = 128, HTB = HALF * BK * 2, STAGE_BYTES = 8 * HTB, NXCD = 8, WGM = 8;
__host__ __device__ __forceinline__ int lds_byte(int r, int c) { const int st = (r >> 4) * 2 + (c >> 5), rr = r & 15, cc = c & 31, ob = rr * 64 + cc * 2; return st * 1024 + (ob ^ (((ob >> 9) & 1) << 5)); }
__host__ __device__ __forceinline__ void stage_rc(int b, int& R, int& C) { const int st = b / 1024, sb = b % 1024, swz = sb ^ (((sb >> 9) & 1) << 5); R = (st >> 1) * 16 + swz / 64; C = (st & 1) * 32 + (swz % 64) / 2; }
__host__ __device__ __forceinline__ int perm32(int rho) { const int n = rho >> 4, i = rho & 15; return 8 * (i >> 2) + 4 * n + (i & 3); }

struct Unit { int pm, pn, p; const char* a; const char* b; };

struct StdOrder {
    int nM, nN, nwg, G, c; const char* A; const char* B; size_t tA, tB;
    __device__ __forceinline__ void init(int Mr, int Nc, int G_, int c_, const void* A_, const void* B_, int lda, int ldb) { nM = Mr / BM; nN = Nc / BM; nwg = nM * nN; G = G_; c = c_; A = (const char*)A_; B = (const char*)B_; tA = (size_t)BM * lda * 2; tB = (size_t)BM * ldb * 2; }
    __device__ __forceinline__ bool next(int i, Unit& u) const {
        const long L = (long)i * G + c; if (L >= nwg) return false;
        int wgid = (int)L; { const int q = nwg / NXCD, r = nwg % NXCD, xcd = wgid % NXCD, off = wgid / NXCD; wgid = (xcd < r ? xcd * (q + 1) : r * (q + 1) + (xcd - r) * q) + off; }
        const int nig = WGM * nN, gid = wgid / nig, fm = gid * WGM, gsz = (nM - fm) < WGM ? (nM - fm) : WGM;
        u.pm = fm + ((wgid % nig) % gsz); u.pn = (wgid % nig) / gsz; u.p = 0; u.a = A + (size_t)u.pm * tA; u.b = B + (size_t)u.pn * tB; return true;
    }
};

template <class Epi, class Sched, int LDA, int LDB, int KD, bool ALIGN_EPI>
__device__ __forceinline__ void gemm_phase(PG8_LAS unsigned char* lds, const Sched& S, const Epi& E) {
    int tid = threadIdx.x; asm volatile("" : "+v"(tid));
    const int wid = __builtin_amdgcn_readfirstlane(tid >> 6), lane = tid & 63, wr = wid >> 2, wc = wid & 3, fr = lane & 15, fq = lane >> 4;
    constexpr int nt = KD / BK;
    static_assert(KD % 128 == 0 && KD >= 256, "K multiple of 128, >= 256");
    unsigned voffA[2], voffB[2];
#pragma unroll
    for (int i = 0; i < 2; ++i) { int R, C; stage_rc(tid * 16 + i * 8192, R, C); const int Rb = (R & ~31) + perm32(R & 31);
        voffA[i] = (unsigned)(R * LDA + C) * 2u; voffB[i] = (unsigned)(Rb * LDB + C) * 2u; }
    constexpr size_t kstep = (size_t)(BK * 2), hstepA = (size_t)HALF * LDA * 2, hstepB = (size_t)HALF * LDB * 2;
    const unsigned ldsw = (unsigned)wid * 1024u;
    const int aoff = lds_byte(wr * 64 + fr, fq * 8), boff = lds_byte(wc * 32 + fr, fq * 8);
#define PG8_SA(b, h) (((b) * 2 + (h)) * HTB)
#define PG8_SB(b, h) ((4 + (b) * 2 + (h)) * HTB)
#define PG8_STAGE(bufoff, gbase, voff) do { _Pragma("unroll") for (int _i = 0; _i < 2; ++_i) \
        __builtin_amdgcn_global_load_lds((const unsigned*)((const char*)(gbase) + (voff)[_i]), (PG8_LAS unsigned*)(lds + (bufoff) + ldsw + _i * 8192), 16, 0, 0); } while (0)
#define PG8_LDA(dst, b, h) do { _Pragma("unroll") for (int m = 0; m < 4; ++m) _Pragma("unroll") for (int k = 0; k < 2; ++k) dst[m][k] = *(const PG8_LAS bf16x8*)(lds + PG8_SA(b, h) + aoff + m * 2048 + k * 1024); } while (0)
#define PG8_LDB(dst, b, h) do { _Pragma("unroll") for (int n = 0; n < 2; ++n) _Pragma("unroll") for (int k = 0; k < 2; ++k) dst[n][k] = *(const PG8_LAS bf16x8*)(lds + PG8_SB(b, h) + boff + n * 2048 + k * 1024); } while (0)
#define PG8_MMA(ai, bj, At, Bt) do { __builtin_amdgcn_s_setprio(1); _Pragma("unroll") for (int m = 0; m < 4; ++m) _Pragma("unroll") for (int n = 0; n < 2; ++n) _Pragma("unroll") for (int k = 0; k < 2; ++k) \
        acc[ai][bj][m][n] = __builtin_amdgcn_mfma_f32_16x16x32_bf16(Bt[n][k], At[m][k], acc[ai][bj][m][n], 0, 0, 0); __builtin_amdgcn_s_setprio(0); } while (0)
#define PG8_WAIT_V(n) asm volatile("s_waitcnt vmcnt(" #n ")" ::: "memory")
#define PG8_WAIT_L(n) asm volatile("s_waitcnt lgkmcnt(" #n ")" ::: "memory")
#define PG8_BAR __builtin_amdgcn_s_barrier()
#define PG8_SCHED __builtin_amdgcn_sched_barrier(0)
    Unit cur, nxt; int ui = 0;
    if (!S.next(0, cur)) return;
    f32x4 acc[2][2][4][2];
#pragma unroll
    for (int a = 0; a < 2; ++a)
#pragma unroll
        for (int b = 0; b < 2; ++b)
#pragma unroll
            for (int m = 0; m < 4; ++m)
#pragma unroll
                for (int n = 0; n < 2; ++n) acc[a][b][m][n] = (f32x4){0.f, 0.f, 0.f, 0.f};
    bf16x8 At[4][2], B0[2][2], B1[2][2];
    const char* cA = cur.a; const char* cB = cur.b;
    PG8_STAGE(PG8_SB(0, 0), cB, voffB); PG8_STAGE(PG8_SB(0, 1), cB + hstepB, voffB); PG8_STAGE(PG8_SA(0, 0), cA, voffA); PG8_STAGE(PG8_SA(0, 1), cA + hstepA, voffA);
    if (wr == 1) PG8_BAR;
    PG8_WAIT_V(2); PG8_BAR;
    PG8_STAGE(PG8_SB(1, 0), cB + kstep, voffB); PG8_STAGE(PG8_SA(1, 0), cA + kstep, voffA); PG8_STAGE(PG8_SB(1, 1), cB + hstepB + kstep, voffB);
    PG8_WAIT_V(6); PG8_BAR;
    for (;;) {
        const bool has_next = S.next(ui + 1, nxt);
        const char* nA = has_next ? nxt.a : cA; const char* nB = has_next ? nxt.b : cB;
#pragma nounroll
        for (int t = 0; t < nt; t += 2) {
            const bool last = (t == nt - 2);
            const char* a1 = cA + (size_t)(t + 1) * kstep;
            const char* a2 = last ? nA : cA + (size_t)(t + 2) * kstep; const char* b2 = last ? nB : cB + (size_t)(t + 2) * kstep;
            const char* a3 = a2 + kstep; const char* b3 = b2 + kstep;
            PG8_LDB(B0, 0, 0); PG8_LDB(B1, 0, 1); PG8_SCHED; PG8_LDA(At, 0, 0); PG8_STAGE(PG8_SA(1, 1), a1 + hstepA, voffA);
            PG8_WAIT_V(8); PG8_WAIT_L(0); PG8_BAR; PG8_MMA(0, 0, At, B0); PG8_MMA(0, 1, At, B1); PG8_BAR; PG8_SCHED;
            PG8_LDA(At, 0, 1); PG8_STAGE(PG8_SB(0, 0), b2, voffB); PG8_STAGE(PG8_SB(0, 1), b2 + hstepB, voffB); PG8_STAGE(PG8_SA(0, 0), a2, voffA);
            PG8_WAIT_V(8); PG8_WAIT_L(0); PG8_BAR; PG8_MMA(1, 0, At, B0); PG8_MMA(1, 1, At, B1); PG8_BAR; PG8_SCHED;
            PG8_LDB(B0, 1, 0); PG8_LDB(B1, 1, 1); PG8_SCHED; PG8_LDA(At, 1, 0); PG8_STAGE(PG8_SA(0, 1), a2 + hstepA, voffA);
            PG8_WAIT_V(8); PG8_WAIT_L(0); PG8_BAR; PG8_MMA(0, 0, At, B0); PG8_MMA(0, 1, At, B1); PG8_BAR; PG8_SCHED;
            PG8_LDA(At, 1, 1); PG8_STAGE(PG8_SB(1, 0), b3, voffB); PG8_STAGE(PG8_SB(1, 1), b3 + hstepB, voffB); PG8_STAGE(PG8_SA(1, 0), a3, voffA);
            PG8_WAIT_V(8); PG8_WAIT_L(0); PG8_BAR; PG8_MMA(1, 0, At, B0); PG8_MMA(1, 1, At, B1); PG8_BAR; PG8_SCHED;
        }
        if constexpr (ALIGN_EPI) { if (wr == 0) PG8_BAR; }
        E(acc, cur, wr, wc, fr, fq);
        if (!has_next) break;
#pragma unroll
        for (int a = 0; a < 2; ++a)
#pragma unroll
            for (int b = 0; b < 2; ++b)
#pragma unroll
                for (int m = 0; m < 4; ++m)
#pragma unroll
                    for (int n = 0; n < 2; ++n) acc[a][b][m][n] = (f32x4){0.f, 0.f, 0.f, 0.f};
        cur = nxt; cA = nA; cB = nB; ++ui;
        if constexpr (ALIGN_EPI) { if (wr == 1) PG8_BAR; }
    }
    PG8_WAIT_V(0);
    if constexpr (!ALIGN_EPI) { if (wr == 0) PG8_BAR; }
    PG8_BAR;
#undef PG8_SA
#undef PG8_SB
#undef PG8_STAGE
#undef PG8_LDA
#undef PG8_LDB
#undef PG8_MMA
#undef PG8_WAIT_V
#undef PG8_WAIT_L
#undef PG8_BAR
#undef PG8_SCHED
}
typedef f32x4 Acc[2][2][4][2];
}
using pg8::Unit;

__device__ __forceinline__ void rinv_rows(const float* ssq, int rowbase, int fq, float (&ri)[2][4]) {
#pragma unroll
    for (int ai = 0; ai < 2; ++ai)
#pragma unroll
        for (int m = 0; m < 4; ++m) { const f32x4 v = *(const f32x4*)(ssq + (size_t)(rowbase + ai * 128 + m * 16) * 16 + fq * 4);
            float s = (v[0] + v[1]) + (v[2] + v[3]); s += __shfl_xor(s, 16); s += __shfl_xor(s, 32); ri[ai][m] = rinv_of(s); }
}
__device__ __forceinline__ void rinv_cols(const float* ssq, int colbase  , int fr, int lane, float (&rc)[2][8]) {
    const int tok = colbase + 128 * (fr >> 3) + (fr & 7); const f32x4* p = (const f32x4*)(ssq + (size_t)tok * 16);
    const f32x4 a = p[0], b = p[1], c = p[2], d = p[3];
    const float s = (((a[0] + a[1]) + (a[2] + a[3])) + ((b[0] + b[1]) + (b[2] + b[3]))) + (((c[0] + c[1]) + (c[2] + c[3])) + ((d[0] + d[1]) + (d[2] + d[3])));
    const float r = rinv_of(s);
#pragma unroll
    for (int bj = 0; bj < 2; ++bj)
#pragma unroll
        for (int q = 0; q < 8; ++q) rc[bj][q] = __shfl(r, (lane & 48) | (bj * 8 + q));
}
__device__ __forceinline__ void sincos_rev(float ang, float& sn, float& cs) { float rev = ang * INV2PI; rev = __builtin_amdgcn_fractf(rev); sn = __builtin_amdgcn_sinf(rev); cs = __builtin_amdgcn_cosf(rev); }

struct EpiQKV { static constexpr bool PERM = true; bf16_t* q; const float* ssq;
    __device__ __forceinline__ void operator()(const pg8::Acc& acc, const Unit& u, int wr, int wc, int fr, int fq) const {
        asm volatile("" : "+v"(fr), "+v"(fq));
        const int t = u.pn >> 2; bf16_t* base = q + (size_t)t * ((WS_K - WS_Q) / 2); const float sc = t == 0 ? C2 : 1.f;
        const int row0 = u.pm * 256 + wr * 64 + fr, col0 = (u.pn & 3) * 256 + wc * 32 + 8 * fq;
        float ri[2][4]; rinv_rows(ssq, row0, fq, ri);
#pragma unroll
        for (int ai = 0; ai < 2; ++ai)
#pragma unroll
            for (int m = 0; m < 4; ++m) { const float s = ri[ai][m] * sc; bf16_t* rowp = base + (size_t)(row0 + ai * 128 + m * 16) * D + col0;
#pragma unroll
                for (int bj = 0; bj < 2; ++bj) *(u32x4*)(rowp + bj * 128) = pack8(acc[ai][bj][m][0] * s, acc[ai][bj][m][1] * s); }
    }
};
struct EpiRes { static constexpr bool PERM = true; const float* base; float* out; bf16_t* hbf; float* ssq;
    __device__ __forceinline__ void operator()(const pg8::Acc& acc, const Unit& u, int wr, int wc, int fr, int fq) const {
        asm volatile("" : "+v"(fr), "+v"(fq));
        const int row0 = u.pm * 256 + wr * 64 + fr, col0 = u.pn * 256 + wc * 32 + 8 * fq;
        f32x4 nb[4];
        { const size_t off = (size_t)row0 * D + col0;
#pragma unroll
          for (int bj = 0; bj < 2; ++bj) { nb[2 * bj] = *(const f32x4*)(base + off + bj * 128); nb[2 * bj + 1] = *(const f32x4*)(base + off + bj * 128 + 4); } }
#pragma unroll
        for (int g = 0; g < 8; ++g) { const int ai = g >> 2, m = g & 3; const int row = row0 + ai * 128 + m * 16; const size_t off = (size_t)row * D + col0; float ss = 0.f;
            f32x4 cb[4];
#pragma unroll
            for (int k = 0; k < 4; ++k) cb[k] = nb[k];
            if (g < 7) { const size_t noff = (size_t)(row0 + ((g + 1) >> 2) * 128 + ((g + 1) & 3) * 16) * D + col0;
#pragma unroll
                for (int bj = 0; bj < 2; ++bj) { nb[2 * bj] = *(const f32x4*)(base + noff + bj * 128); nb[2 * bj + 1] = *(const f32x4*)(base + noff + bj * 128 + 4); } }
            asm volatile("" ::: "memory");
#pragma unroll
            for (int bj = 0; bj < 2; ++bj) { const f32x4 h0 = cb[2 * bj] + acc[ai][bj][m][0], h1 = cb[2 * bj + 1] + acc[ai][bj][m][1];
                *(f32x4*)(out + off + bj * 128) = h0; *(f32x4*)(out + off + bj * 128 + 4) = h1; *(u32x4*)(hbf + off + bj * 128) = pack8(h0, h1);
                ss += ((h0[0] * h0[0] + h0[1] * h0[1]) + (h0[2] * h0[2] + h0[3] * h0[3])) + ((h1[0] * h1[0] + h1[1] * h1[1]) + (h1[2] * h1[2] + h1[3] * h1[3])); }
            ss += __shfl_xor(ss, 16); ss += __shfl_xor(ss, 32); if (fq == 0) ssq[(size_t)row * 16 + u.pn * 4 + wc] = ss; }
    }
};
struct EpiUp { static constexpr bool PERM = true; bf16_t* uo; const float* ssq;
    __device__ __forceinline__ void operator()(const pg8::Acc& acc, const Unit& u, int wr, int wc, int fr, int fq) const {
        asm volatile("" : "+v"(fr), "+v"(fq));
        const int row0 = u.pm * 256 + wr * 64 + fr, col0 = u.pn * 256 + wc * 32 + 8 * fq;
        float ri[2][4]; rinv_rows(ssq, row0, fq, ri);
#pragma unroll
        for (int ai = 0; ai < 2; ++ai)
#pragma unroll
            for (int m = 0; m < 4; ++m) { const float s = ri[ai][m]; bf16_t* rowp = uo + (size_t)(row0 + ai * 128 + m * 16) * FF + col0;
#pragma unroll
                for (int bj = 0; bj < 2; ++bj) { f32x4 a = acc[ai][bj][m][0] * s, b = acc[ai][bj][m][1] * s;
#pragma unroll
                    for (int e = 0; e < 4; ++e) { const float x = fmaxf(a[e], 0.f), y = fmaxf(b[e], 0.f); a[e] = x * x; b[e] = y * y; }
                    *(u32x4*)(rowp + bj * 128) = pack8(a, b); } }
    }
};
struct EpiRetQK { static constexpr bool PERM = true; bf16_t* SQ; bf16_t* KN; const float* ssq;
    __device__ __forceinline__ void operator()(const pg8::Acc& acc, const Unit& u, int wr, int wc, int fr, int fq) const {
        asm volatile("" : "+v"(fr), "+v"(fq));
        const bool isq = u.pn < 4; const int h = u.pn & 3, b = u.pm >> 4, N = u.pm & 15, p = (b * 4 + h) * 16 + N;
        const int row0 = u.pm * 256 + wr * 64 + fr, i0 = wr * 64 + fr, cb = wc * 32 + 8 * fq; const float lg = lg2gamma(h);
        float ri[2][4]; rinv_rows(ssq, row0, fq, ri);
        float invf[8];
#pragma unroll
        for (int q = 0; q < 8; ++q) invf[q] = __builtin_amdgcn_exp2f(-(float)(cb + q) * L2B127);
#pragma unroll
        for (int ai = 0; ai < 2; ++ai)
#pragma unroll
            for (int m = 0; m < 4; ++m) { const int il = i0 + ai * 128 + m * 16; const float pos = (float)(N * 256 + il);
                const float s = ri[ai][m], sc = isq ? __builtin_amdgcn_exp2f(lg * (float)(il + 1)) : 0.0625f;
                f32x4 y1[2], y2[2];
#pragma unroll
                for (int n = 0; n < 2; ++n)
#pragma unroll
                    for (int e = 0; e < 4; ++e) { float sn, cs; sincos_rev(pos * invf[n * 4 + e], sn, cs); const float x1 = acc[ai][0][m][n][e] * s, x2 = acc[ai][1][m][n][e] * s;
                        y1[n][e] = (x1 * cs - x2 * sn) * sc; y2[n][e] = (x1 * sn + x2 * cs) * sc; }
                bf16_t* dst = isq ? SQ + (size_t)p * SQ_P + (size_t)il * 512 + 256 + cb : KN + (size_t)(row0 + ai * 128 + m * 16) * 1024 + h * 256 + cb;
                *(u32x4*)dst = pack8(y1[0], y1[1]); *(u32x4*)(dst + 128) = pack8(y2[0], y2[1]);
                if (!isq) {
                    const float kd = __builtin_amdgcn_exp2f(lg * (float)(255 - il)); bf16_t* tb = SQ + (size_t)p * SQ_P + (size_t)cb * 512 + il;
#pragma unroll
                    for (int n = 0; n < 2; ++n)
#pragma unroll
                        for (int e = 0; e < 4; e += 2) { const unsigned w1 = cvt_pk_bf16(y1[n][e] * kd, y1[n][e + 1] * kd), w2 = cvt_pk_bf16(y2[n][e] * kd, y2[n][e + 1] * kd); const int dq = n * 4 + e;
                            tb[(size_t)dq * 512] = (bf16_t)(w1 & 0xffffu); tb[(size_t)(dq + 1) * 512] = (bf16_t)(w1 >> 16);
                            tb[(size_t)(128 + dq) * 512] = (bf16_t)(w2 & 0xffffu); tb[(size_t)(129 + dq) * 512] = (bf16_t)(w2 >> 16); } }
                __builtin_amdgcn_sched_barrier(0); }
    }
};
struct EpiRetVt { static constexpr bool PERM = true; bf16_t* VS; const float* ssq;
    __device__ __forceinline__ void operator()(const pg8::Acc& acc, const Unit& u, int wr, int wc, int fr, int fq) const {
        asm volatile("" : "+v"(fr), "+v"(fq));
        const int lane = fq * 16 + fr; const int b = u.pn >> 4, N = u.pn & 15, jb = wc * 32 + 8 * fq;
        float rc[2][8]; rinv_cols(ssq, u.pn * 256 + jb, fr, lane, rc);
        const int h = u.pm >> 1, eh = u.pm & 1, p = (b * 4 + h) * 16 + N;
#pragma unroll
        for (int ai = 0; ai < 2; ++ai)
#pragma unroll
            for (int m = 0; m < 4; ++m) { const int e_row = eh * 256 + ai * 128 + wr * 64 + m * 16 + fr;
#pragma unroll
                for (int bj = 0; bj < 2; ++bj) { f32x4 a = acc[ai][bj][m][0], c = acc[ai][bj][m][1];
#pragma unroll
                    for (int e = 0; e < 4; ++e) { a[e] *= rc[bj][e]; c[e] *= rc[bj][4 + e]; }
                    *(u32x4*)(VS + (size_t)p * VS_P + (size_t)e_row * 512 + bj * 128 + jb) = pack8(a, c); } }
    }
};
struct EpiKV { static constexpr bool PERM = true; bf16_t* VS;
    __device__ __forceinline__ void operator()(const pg8::Acc& acc, const Unit& u, int wr, int wc, int fr, int fq) const {
        asm volatile("" : "+v"(fr), "+v"(fq));
        bf16_t* base = VS + (size_t)u.p * VS_P + 256 + wc * 32 + 8 * fq;
#pragma unroll
        for (int ai = 0; ai < 2; ++ai)
#pragma unroll
            for (int m = 0; m < 4; ++m) { const int e_row = u.pm * 256 + ai * 128 + wr * 64 + m * 16 + fr;
#pragma unroll
                for (int bj = 0; bj < 2; ++bj) *(u32x4*)(base + (size_t)e_row * 512 + bj * 128) = pack8(acc[ai][bj][m][0], acc[ai][bj][m][1]); }
    }
};
struct EpiS { static constexpr bool PERM = true; bf16_t* SQ;
    __device__ __forceinline__ void operator()(const pg8::Acc& acc, const Unit& u, int wr, int wc, int fr, int fq) const {
        asm volatile("" : "+v"(fr), "+v"(fq));
        const int h = (u.p >> 4) & 3, jb = wc * 32 + 8 * fq; const float lg = lg2gamma(h);
        float gi[2][8];
#pragma unroll
        for (int bj = 0; bj < 2; ++bj)
#pragma unroll
            for (int q = 0; q < 8; ++q) gi[bj][q] = __builtin_amdgcn_exp2f(-lg * (float)(bj * 128 + jb + q + 1));
#pragma unroll
        for (int ai = 0; ai < 2; ++ai)
#pragma unroll
            for (int m = 0; m < 4; ++m) { const int i = ai * 128 + wr * 64 + m * 16 + fr;
#pragma unroll
                for (int bj = 0; bj < 2; ++bj) { f32x4 a = acc[ai][bj][m][0], c = acc[ai][bj][m][1];
#pragma unroll
                    for (int e = 0; e < 4; ++e) { const int d0 = i - (bj * 128 + jb + e);
                        a[e] = __uint_as_float(__float_as_uint(a[e] * gi[bj][e]) & ~(unsigned)(d0 >> 31)); c[e] = __uint_as_float(__float_as_uint(c[e] * gi[bj][4 + e]) & ~(unsigned)((d0 - 4) >> 31)); }
                    *(u32x4*)(SQ + (size_t)u.p * SQ_P + (size_t)i * 512 + bj * 128 + jb) = pack8(a, c); } __builtin_amdgcn_sched_barrier(0); }
    }
};
struct EpiO { static constexpr bool PERM = true; bf16_t* SQ; bf16_t* OH0; float* GN;
    __device__ __forceinline__ void operator()(const pg8::Acc& acc, const Unit& u, int wr, int wc, int fr, int fq) const {
        asm volatile("" : "+v"(fr), "+v"(fq));
        const int bh = u.p >> 4, N = u.p & 15, b = bh >> 2, h = bh & 3, cb = wc * 32 + 8 * fq;
        bf16_t* ob = u.pn == 0 ? OH0 + (size_t)u.p * 65536 : SQ + (size_t)u.p * SQ_P; const int pitch = u.pn == 0 ? 256 : 512;
#pragma unroll
        for (int ai = 0; ai < 2; ++ai)
#pragma unroll
            for (int m = 0; m < 4; ++m) { const int i = ai * 128 + wr * 64 + m * 16 + fr; float s = 0.f, q = 0.f;
#pragma unroll
                for (int bj = 0; bj < 2; ++bj) { const f32x4 a = acc[ai][bj][m][0], c = acc[ai][bj][m][1];
                    s += ((a[0] + a[1]) + (a[2] + a[3])) + ((c[0] + c[1]) + (c[2] + c[3]));
                    q += ((a[0] * a[0] + a[1] * a[1]) + (a[2] * a[2] + a[3] * a[3])) + ((c[0] * c[0] + c[1] * c[1]) + (c[2] * c[2] + c[3] * c[3]));
                    *(u32x4*)(ob + (size_t)i * pitch + bj * 128 + cb) = pack8(a, c); }
                s += __shfl_xor(s, 16); s += __shfl_xor(s, 32); q += __shfl_xor(q, 16); q += __shfl_xor(q, 32);
                if (fq == 0) { const size_t tok = (size_t)b * SEQ + N * 256 + i; *(f32x2*)(GN + (tok * 4 + h) * 16 + (u.pn * 4 + wc) * 2) = (f32x2){s, q}; } }
    }
};
struct EpiG { static constexpr bool PERM = true; const bf16_t* SQ; const bf16_t* OH0; const float* GN; const float* ssq; bf16_t* Y;
    __device__ __forceinline__ void operator()(const pg8::Acc& acc, const Unit& u, int wr, int wc, int fr, int fq) const {
        asm volatile("" : "+v"(fr), "+v"(fq));
        const int b = u.pm >> 4, N = u.pm & 15, h = u.pn >> 1, eh = u.pn & 1, p = (b * 4 + h) * 16 + N, cb = wc * 32 + 8 * fq;
        const int row0 = u.pm * 256 + wr * 64 + fr, i0 = wr * 64 + fr;
        float ri[2][4]; rinv_rows(ssq, row0, fq, ri);
        const bf16_t* ob = (eh == 0 ? OH0 + (size_t)p * 65536 : SQ + (size_t)p * SQ_P) + cb; const int pitch = eh == 0 ? 256 : 512;
        const float* gnb = GN + ((size_t)row0 * 4 + h) * 16 + fq * 4;
        u32x4 no[2]; f32x4 nst;
        no[0] = *(const u32x4*)(ob + (size_t)i0 * pitch); no[1] = *(const u32x4*)(ob + (size_t)i0 * pitch + 128); nst = *(const f32x4*)gnb;
#pragma unroll
        for (int g = 0; g < 8; ++g) { const int ai = g >> 2, m = g & 3; const size_t tok = (size_t)row0 + ai * 128 + m * 16;
            const u32x4 co[2] = {no[0], no[1]}; const f32x4 st = nst;
            if (g < 7) { const int r1 = ((g + 1) >> 2) * 128 + ((g + 1) & 3) * 16;
                no[0] = *(const u32x4*)(ob + (size_t)(i0 + r1) * pitch); no[1] = *(const u32x4*)(ob + (size_t)(i0 + r1) * pitch + 128); nst = *(const f32x4*)(gnb + (size_t)r1 * 64); }
            asm volatile("" ::: "memory");
            float s = st[0] + st[2], q = st[1] + st[3];
            s += __shfl_xor(s, 16); s += __shfl_xor(s, 32); q += __shfl_xor(q, 16); q += __shfl_xor(q, 32);
            const float mu = s * (1.0f / RDV), var = fmaxf(q * (1.0f / RDV) - mu * mu, 0.f), rstd = 1.0f / sqrtf(var + GN_EPS), rr = ri[ai][m];
#pragma unroll
            for (int bj = 0; bj < 2; ++bj) { const u32x4 ow = co[bj]; f32x4 a = acc[ai][bj][m][0] * rr, c = acc[ai][bj][m][1] * rr;
                const float o8[8] = {bf_lo(ow.x), bf_hi(ow.x), bf_lo(ow.y), bf_hi(ow.y), bf_lo(ow.z), bf_hi(ow.z), bf_lo(ow.w), bf_hi(ow.w)};
#pragma unroll
                for (int e = 0; e < 4; ++e) { const float g0 = a[e], g1 = c[e];
                    a[e] = g0 * __builtin_amdgcn_rcpf(1.f + __builtin_amdgcn_exp2f(-g0 * LOG2E)) * ((o8[e] - mu) * rstd);
                    c[e] = g1 * __builtin_amdgcn_rcpf(1.f + __builtin_amdgcn_exp2f(-g1 * LOG2E)) * ((o8[4 + e] - mu) * rstd); }
                *(u32x4*)(Y + tok * 2048 + h * 512 + eh * 256 + bj * 128 + cb) = pack8(a, c); } }
    }
};

struct KVOrder { int G, c; const char* VS; const char* SQ;
    __device__ __forceinline__ bool next(int i, Unit& u) const { const int p = c + (i >> 1) * G; if (p >= NPROB) return false; u.p = p; u.pm = i & 1; u.pn = 0;
        u.a = VS + (size_t)p * VS_P * 2 + (size_t)u.pm * 256 * 512 * 2; u.b = SQ + (size_t)p * SQ_P * 2; return true; } };
struct SOrder { int G, c; const char* SQ; const char* KN;
    __device__ __forceinline__ bool next(int i, Unit& u) const { const int p = c + i * G; if (p >= NPROB) return false; u.p = p; u.pm = 0; u.pn = 0;
        const int bh = p >> 4, N = p & 15, b = bh >> 2, h = bh & 3; u.a = SQ + (size_t)p * SQ_P * 2 + 512; u.b = KN + ((size_t)(b * SEQ + N * 256) * 1024 + h * 256) * 2; return true; } };
struct OOrder { int G, c; const char* SQ; const char* VS;
    __device__ __forceinline__ bool next(int i, Unit& u) const { const int p = c + (i >> 1) * G; if (p >= NPROB) return false; u.p = p; u.pm = 0; u.pn = i & 1;
        u.a = SQ + (size_t)p * SQ_P * 2; u.b = VS + (size_t)p * VS_P * 2 + (size_t)u.pn * 256 * 512 * 2; return true; } };

#define XB_TMO      128
#define XB_XCNT(j)  (256  + 64 * (j))
#define XB_XSUB(j)  (1280 + 64 * (j))
#define XB_XGEN(j)  (2304 + 64 * (j))
#define XB_TOP      3328
#define XB_TOPGEN   3392
#define XCD_BAR_WORDS 3456
#define XB_SPIN_CAP (1u << 18)
__device__ __forceinline__ unsigned xb_ld(unsigned* p)              { return __hip_atomic_load(p, __ATOMIC_RELAXED, __HIP_MEMORY_SCOPE_AGENT); }
__device__ __forceinline__ unsigned xb_add(unsigned* p, unsigned v) { return __hip_atomic_fetch_add(p, v, __ATOMIC_RELAXED, __HIP_MEMORY_SCOPE_AGENT); }
__device__ __forceinline__ unsigned xb_xcc_id() { return (unsigned)__builtin_amdgcn_s_getreg((3 << 11) | 20) & 0xFu; }
#define XB_SPIN(cond, bar) do { unsigned _sp = 0; while (cond) { __builtin_amdgcn_s_sleep(1); \
    if ((++_sp & 255u) == 0u) { if (xb_ld(&(bar)[XB_TMO])) break; if (_sp > XB_SPIN_CAP) { atomicAdd(&(bar)[XB_TMO], 1u); break; } } } } while (0)
struct XcdBarrier { unsigned* bar; unsigned x; volatile LAS unsigned* st; };
__device__ __forceinline__ XcdBarrier xcd_barrier_post(unsigned* bar, volatile LAS unsigned* st) {
    XcdBarrier b; b.bar = bar; b.x = xb_xcc_id(); b.st = st;
    if (threadIdx.x == 0) (void)xb_add(&bar[XB_XCNT(b.x)], 1u);
    return b;
}
__device__ __forceinline__ void xcd_barrier_complete(unsigned* bar, unsigned x, unsigned& nloc, unsigned& nx) {
    const unsigned G = gridDim.x * gridDim.y * gridDim.z;
    unsigned sum, cnt, mine, sp = 0u;
    for (;;) {
        sum = 0u; cnt = 0u; mine = 0u;
#pragma unroll
        for (unsigned j = 0; j < 16; ++j) { const unsigned c = xb_ld(&bar[XB_XCNT(j)]); sum += c; cnt += (c > 0u) ? 1u : 0u; mine = (j == x) ? c : mine; }
        if (sum == G) break;
        __builtin_amdgcn_s_sleep(1);
        if ((++sp & 255u) == 0u) { if (xb_ld(&bar[XB_TMO])) break; if (sp > XB_SPIN_CAP) { atomicAdd(&bar[XB_TMO], 1u); break; } }
    }
    nloc = mine > 0u ? mine : 1u; nx = cnt > 0u ? cnt : 1u;
}
__device__ __forceinline__ void xcd_barrier(const XcdBarrier& b) {
    asm volatile("s_waitcnt vmcnt(0)" ::: "memory");
    __syncthreads();
    if (threadIdx.x == 0) {
        unsigned* bar = b.bar;
        __builtin_amdgcn_s_waitcnt(0);
        unsigned nloc = b.st[0], nx = b.st[1];
        if (nloc == 0u) { xcd_barrier_complete(bar, b.x, nloc, nx); b.st[0] = nloc; b.st[1] = nx; }
        const unsigned old = xb_add(&bar[XB_XSUB(b.x)], 1u);
        const unsigned gen = old / nloc;
        if (old + 1u == (gen + 1u) * nloc) {
            __builtin_amdgcn_fence(__ATOMIC_RELEASE, "agent");
            asm volatile("s_waitcnt vmcnt(0)" ::: "memory");
            const unsigned og = xb_add(&bar[XB_TOP], 1u);
            const unsigned tg = og / nx;
            if (og + 1u == (tg + 1u) * nx) xb_add(&bar[XB_TOPGEN], 1u);
            else XB_SPIN(xb_ld(&bar[XB_TOPGEN]) == tg, bar);
            __builtin_amdgcn_fence(__ATOMIC_ACQUIRE, "agent");
            xb_add(&bar[XB_XGEN(b.x)], 1u);
            asm volatile("s_waitcnt vmcnt(0)" ::: "memory");
        } else {
            XB_SPIN(xb_ld(&bar[XB_XGEN(b.x)]) == gen, bar);
            __builtin_amdgcn_fence(__ATOMIC_ACQUIRE, "agent");
            asm volatile("s_waitcnt vmcnt(0)" ::: "memory");
        }
    }
    __syncthreads();
}

__device__ __forceinline__ void transpose_item(const float* W, const float* g, int K, int N, bf16_t* WT, LAS float* scr, int item, int lane) {
    const int nblk = N / 32, kb = item / nblk, nb = item % nblk, k0 = 64 * kb, n0 = 32 * nb;
#pragma unroll 8
    for (int i = 0; i < 32; ++i) { const int kk = 2 * i + (lane >> 5); const float gv = g ? g[k0 + kk] : 1.f; scr[kk * 33 + (lane & 31)] = W[(size_t)(k0 + kk) * N + n0 + (lane & 31)] * gv; }
    LDS_WAIT(); asm volatile("" ::: "memory");
    const int c = lane & 7;
#pragma unroll
    for (int j = 0; j < 4; ++j) { const int n = (lane >> 3) + 8 * j; const LAS float* s = scr + (8 * c) * 33 + n;
        u32x4 o; o.x = cvt_pk_bf16(s[0 * 33], s[1 * 33]); o.y = cvt_pk_bf16(s[2 * 33], s[3 * 33]); o.z = cvt_pk_bf16(s[4 * 33], s[5 * 33]); o.w = cvt_pk_bf16(s[6 * 33], s[7 * 33]);
        *(u32x4*)(WT + (size_t)(n0 + n) * K + k0 + 8 * c) = o; }
    LDS_WAIT(); asm volatile("" ::: "memory");
}
__device__ __forceinline__ void convert_pair(const float* W0, const float* g0, int K0, int N0, bf16_t* T0, const float* W1, const float* g1, int K1, int N1, bf16_t* T1, LAS unsigned char* lds, int gw, int ngw, int wave, int lane) {
    LAS float* scr = (LAS float*)(lds + wave * 16384);
    const int I0 = (K0 / 64) * (N0 / 32), I1 = (K1 / 64) * (N1 / 32);
    for (int it = gw; it < I0 + I1; it += ngw) { if (it < I0) transpose_item(W0, g0, K0, N0, T0, scr, it, lane); else transpose_item(W1, g1, K1, N1, T1, scr, it - I0, lane); }
    __syncthreads();
}
__device__ __forceinline__ void convert_mix(int L, const float* const* in, unsigned char* ws, LAS unsigned char* lds, int gw, int ngw, int wave, int lane) {
    const int i = L >> 1; const float* g = in[5] + (size_t)L * D; bf16_t* T = (bf16_t*)(ws + WS_WMIX);
    if ((L & 1) == 0) convert_pair(in[1] + (size_t)i * D * 3 * D, g, D, 3 * D, T, in[2] + (size_t)i * D * D, nullptr, D, D, T + (size_t)3 * D * D, lds, gw, ngw, wave, lane);
    else convert_pair(in[3] + (size_t)i * D * 6 * D, g, D, 6 * D, T, in[4] + (size_t)i * 2 * D * D, nullptr, 2 * D, D, T + (size_t)6 * D * D, lds, gw, ngw, wave, lane);
}
__device__ __forceinline__ void convert_mlp(int L, const float* const* in, unsigned char* ws, LAS unsigned char* lds, int gw, int ngw, int wave, int lane) {
    bf16_t* T = (bf16_t*)(ws + WS_WMLP);
    convert_pair(in[7] + (size_t)L * D * FF, in[6] + (size_t)L * D, D, FF, T, in[8] + (size_t)L * FF * D, nullptr, FF, D, T + (size_t)FF * D, lds, gw, ngw, wave, lane);
}
__device__ __forceinline__ void p0_rows(const float* x, bf16_t* hbf, float* ssq, int gw, int ngw, int lane) {
    for (int m = gw; m < M; m += ngw) { const f32x4* xr = (const f32x4*)(x + (size_t)m * D) + lane; f32x4 v[4]; float s = 0.f;
#pragma unroll
        for (int j = 0; j < 4; ++j) { v[j] = xr[64 * j]; s += (v[j][0] * v[j][0] + v[j][1] * v[j][1]) + (v[j][2] * v[j][2] + v[j][3] * v[j][3]); }
        s = wave_sum(s);
        u32x2* o8 = (u32x2*)(hbf + (size_t)m * D) + lane;
#pragma unroll
        for (int j = 0; j < 4; ++j) { u32x2 w; w.x = cvt_pk_bf16(v[j][0], v[j][1]); w.y = cvt_pk_bf16(v[j][2], v[j][3]); o8[64 * j] = w; }
        if (lane < 16) ssq[(size_t)m * 16 + lane] = lane == 0 ? s : 0.f; }
}
__device__ __forceinline__ void final_rows(float* out, const float* ssq, const float* gf, int gw, int ngw, int lane) {
    for (int m = gw; m < M; m += ngw) { float s = ssq[(size_t)m * 16 + (lane & 15)]; s += __shfl_xor(s, 1); s += __shfl_xor(s, 2); s += __shfl_xor(s, 4); s += __shfl_xor(s, 8);
        const float r = rinv_of(s); f32x4* xr = (f32x4*)(out + (size_t)m * D) + lane; const f32x4* gr = (const f32x4*)gf + lane;
#pragma unroll
        for (int j = 0; j < 4; ++j) xr[64 * j] = xr[64 * j] * r * gr[64 * j]; }
}
__device__ __forceinline__ void ret_scan(bf16_t* VS, int gtid, int gthreads) {
    for (int g = gtid; g < BATCH * RH * RDV * 32; g += gthreads) { const int bh = g >> 14, rem = g & 16383, e = rem >> 5, dg = rem & 31, h = bh & 3;
        const float dec = __builtin_amdgcn_exp2f(256.f * lg2gamma(h));
        bf16_t* p = VS + (size_t)bh * 16 * VS_P + (size_t)e * 512 + 256 + dg * 8; float st[8];
#pragma unroll
        for (int k = 0; k < 8; ++k) st[k] = 0.f;
        u32x4 w[16];
#pragma unroll
        for (int N = 0; N < 16; ++N) w[N] = *(const u32x4*)(p + (size_t)N * VS_P);
#pragma unroll
        for (int N = 0; N < 16; ++N) { u32x4 o; o.x = cvt_pk_bf16(st[0], st[1]); o.y = cvt_pk_bf16(st[2], st[3]); o.z = cvt_pk_bf16(st[4], st[5]); o.w = cvt_pk_bf16(st[6], st[7]);
            *(u32x4*)(p + (size_t)N * VS_P) = o;
            st[0] = dec * st[0] + bf_lo(w[N].x); st[1] = dec * st[1] + bf_hi(w[N].x); st[2] = dec * st[2] + bf_lo(w[N].y); st[3] = dec * st[3] + bf_hi(w[N].y);
            st[4] = dec * st[4] + bf_lo(w[N].z); st[5] = dec * st[5] + bf_hi(w[N].z); st[6] = dec * st[6] + bf_lo(w[N].w); st[7] = dec * st[7] + bf_hi(w[N].w); } }
}
__device__ __forceinline__ void sb_attn_simple(const bf16_t* Q, const bf16_t* K, const bf16_t* V, bf16_t* O, int gw, int ngw, int lane) {
    for (int task = gw; task < BATCH * SBH * (SEQ / 64); task += ngw) {
        const int bh = task >> 6, qb = task & 63, b = bh >> 4, h = bh & 15, q0 = qb * 64, t = q0 + lane;
        const size_t rowoff = ((size_t)b * SEQ + t) * D + h * SBD;
        float q[64], o[64];
#pragma unroll
        for (int i = 0; i < 8; ++i) { const u32x4 w = *(const u32x4*)(Q + rowoff + i * 8); q[8 * i + 0] = bf_lo(w.x); q[8 * i + 1] = bf_hi(w.x); q[8 * i + 2] = bf_lo(w.y); q[8 * i + 3] = bf_hi(w.y);
            q[8 * i + 4] = bf_lo(w.z); q[8 * i + 5] = bf_hi(w.z); q[8 * i + 6] = bf_lo(w.w); q[8 * i + 7] = bf_hi(w.w); }
#pragma unroll
        for (int i = 0; i < 64; ++i) o[i] = 0.f;
        float carry = 0.f;
        const bf16_t* Kb = K + (size_t)b * SEQ * D + h * SBD; const bf16_t* Vb = V + (size_t)b * SEQ * D + h * SBD;
        for (int s = q0 + 62; s >= 0; --s) {
            const u32x4* kr = (const u32x4*)(Kb + (size_t)s * D); float z0 = 0.f, z1 = 0.f;
#pragma unroll
            for (int i = 0; i < 8; ++i) { const u32x4 w = kr[i];
                z0 += q[8 * i + 0] * bf_lo(w.x); z1 += q[8 * i + 1] * bf_hi(w.x); z0 += q[8 * i + 2] * bf_lo(w.y); z1 += q[8 * i + 3] * bf_hi(w.y);
                z0 += q[8 * i + 4] * bf_lo(w.z); z1 += q[8 * i + 5] * bf_hi(w.z); z0 += q[8 * i + 6] * bf_lo(w.w); z1 += q[8 * i + 7] * bf_hi(w.w); }
            const float z = z0 + z1;
            const float l = __builtin_amdgcn_logf(1.f + __builtin_amdgcn_exp2f(-fabsf(z)));
            const float lk = -(fmaxf(z, 0.f) + l);
            const bool valid = s < t;
            const float a = valid ? __builtin_amdgcn_exp2f((z + lk) + carry) : 0.f;
            carry += valid ? lk : 0.f;
            const u32x4* vr = (const u32x4*)(Vb + (size_t)s * D);
#pragma unroll
            for (int i = 0; i < 8; ++i) { const u32x4 w = vr[i];
                o[8 * i + 0] += a * bf_lo(w.x); o[8 * i + 1] += a * bf_hi(w.x); o[8 * i + 2] += a * bf_lo(w.y); o[8 * i + 3] += a * bf_hi(w.y);
                o[8 * i + 4] += a * bf_lo(w.z); o[8 * i + 5] += a * bf_hi(w.z); o[8 * i + 6] += a * bf_lo(w.w); o[8 * i + 7] += a * bf_hi(w.w); }
            if (__all(carry < -152.f)) break;
        }
#pragma unroll
        for (int i = 0; i < 8; ++i) { u32x4 w; w.x = cvt_pk_bf16(o[8 * i + 0], o[8 * i + 1]); w.y = cvt_pk_bf16(o[8 * i + 2], o[8 * i + 3]); w.z = cvt_pk_bf16(o[8 * i + 4], o[8 * i + 5]); w.w = cvt_pk_bf16(o[8 * i + 6], o[8 * i + 7]);
            *(u32x4*)(O + rowoff + i * 8) = w; }
    }
}


typedef float f32x16 __attribute__((ext_vector_type(16)));
typedef short v4i16_t __attribute__((ext_vector_type(4)));
__device__ __forceinline__ v4i16_t vtr(const LAS unsigned char* p) { return __builtin_amdgcn_ds_read_tr16_b64_v4i16((LAS v4i16_t*)p); }
__device__ __forceinline__ float lane_partner(float mine) {
    const unsigned m = __float_as_uint(mine); const auto rr = __builtin_amdgcn_permlane32_swap(m, m, false, false); return __uint_as_float(rr[0] ^ rr[1] ^ m);
}
template <bool DIAG> __device__ __forceinline__ void sb_tile_math(float (&zz)[32], float& carry, int qlim, int hi, float m0) {
    float lk[32];
#pragma unroll
    for (int n = 0; n < 32; ++n) { const float z = zz[n];
        const float l = __builtin_amdgcn_logf(1.f + __builtin_amdgcn_exp2f(-fabsf(z)));
        float k = -(fmaxf(z, 0.f) + l), s = z + k;
        if (DIAG) { const bool v = ((n & 3) + 8 * ((n & 15) >> 2) + 32 * (n >> 4)) < qlim; k = v ? k : 0.f; s = v ? s : -INFINITY; }
        lk[n] = k; zz[n] = s; }
    float W = 0.f, off[8];
#pragma unroll
    for (int i = 7; i >= 0; --i) { const float t = ((lk[4 * i + 3] + lk[4 * i + 2]) + lk[4 * i + 1]) + lk[4 * i]; const float other = lane_partner(t); off[i] = carry + (W + m0 * other); W += t + other; }
    carry += W;
#pragma unroll
    for (int i = 0; i < 8; ++i) { const float bs = off[i], a = lk[4 * i + 3], b = a + lk[4 * i + 2], c = b + lk[4 * i + 1];
        zz[4 * i + 3] = __builtin_amdgcn_exp2f(zz[4 * i + 3] + bs); zz[4 * i + 2] = __builtin_amdgcn_exp2f(zz[4 * i + 2] + (bs + a));
        zz[4 * i + 1] = __builtin_amdgcn_exp2f(zz[4 * i + 1] + (bs + b)); zz[4 * i] = __builtin_amdgcn_exp2f(zz[4 * i] + (bs + c)); }
}
__device__ __forceinline__ void sb_load_tile(bf16x8 (&kf)[8], u32x4 (&vv)[8], const bf16_t* Kh, const bf16_t* Vh, int j, int lane) {
    const int r32 = lane & 31, hi = lane >> 5;
    const bf16_t* kp = Kh + (size_t)(64 * j + r32) * D + 8 * hi;
#pragma unroll
    for (int d0 = 0; d0 < 4; ++d0) { kf[2 * d0] = *(const bf16x8*)(kp + 16 * d0); kf[2 * d0 + 1] = *(const bf16x8*)(kp + (size_t)32 * D + 16 * d0); }
    const bf16_t* vp = Vh + (size_t)(64 * j + (lane >> 2)) * D + (lane & 3) * 8;
#pragma unroll
    for (int w = 0; w < 8; ++w) vv[w] = *(const u32x4*)(vp + (size_t)(16 * (w & 3)) * D + (w >> 2) * 32);
}
template <bool DIAG> __device__ __forceinline__ void sb_tile(const bf16x8 (&kf)[8], const bf16x8 (&qr)[4], const LAS unsigned char* vp0, f32x16& o0, f32x16& o1, float& carry, int qlim, int hi, float m0) {
    f32x16 p0 = {0.f, 0.f, 0.f, 0.f, 0.f, 0.f, 0.f, 0.f, 0.f, 0.f, 0.f, 0.f, 0.f, 0.f, 0.f, 0.f}, p1 = p0;
#pragma unroll
    for (int d0 = 0; d0 < 4; ++d0) { p0 = __builtin_amdgcn_mfma_f32_32x32x16_bf16(kf[2 * d0], qr[d0], p0, 0, 0, 0); p1 = __builtin_amdgcn_mfma_f32_32x32x16_bf16(kf[2 * d0 + 1], qr[d0], p1, 0, 0, 0); }
    float zz[32];
#pragma unroll
    for (int r = 0; r < 16; ++r) { zz[r] = p0[r]; zz[16 + r] = p1[r]; }
    sb_tile_math<DIAG>(zz, carry, qlim, hi, m0);
    u32x4 pw[4];
#pragma unroll
    for (int k = 0; k < 4; ++k) { pw[k].x = cvt_pk_bf16(zz[8 * k + 0], zz[8 * k + 1]); pw[k].y = cvt_pk_bf16(zz[8 * k + 2], zz[8 * k + 3]); pw[k].z = cvt_pk_bf16(zz[8 * k + 4], zz[8 * k + 5]); pw[k].w = cvt_pk_bf16(zz[8 * k + 6], zz[8 * k + 7]); }
#pragma unroll
    for (int d0 = 0; d0 < 2; ++d0)
#pragma unroll
        for (int ks = 0; ks < 4; ++ks) { const v4i16_t lo = vtr(vp0 + d0 * 4096 + ks * 1024), hh = vtr(vp0 + d0 * 4096 + ks * 1024 + 512);
            const bf16x8 vf = (bf16x8){lo[0], lo[1], lo[2], lo[3], hh[0], hh[1], hh[2], hh[3]};
            if (d0 == 0) o0 = __builtin_amdgcn_mfma_f32_32x32x16_bf16(__builtin_bit_cast(bf16x8, pw[ks]), vf, o0, 0, 0, 0);
            else o1 = __builtin_amdgcn_mfma_f32_32x32x16_bf16(__builtin_bit_cast(bf16x8, pw[ks]), vf, o1, 0, 0, 0); }
}
__device__ __forceinline__ void sb_attn_mfma(const bf16_t* Q, const bf16_t* K, const bf16_t* V, bf16_t* O, LAS unsigned char* lds, int gw, int ngw, int wave, int lane_in) {
    LAS unsigned char* vb = lds + wave * 8192;
    for (int unit = gw; unit < BATCH * SBH * (SEQ / 32); unit += ngw) {
        int lane = lane_in; asm volatile("" : "+v"(lane));
        const int r32 = lane & 31, hi = lane >> 5; const float m0 = hi == 0 ? 1.f : 0.f;
        const LAS unsigned char* vp0 = vb + ((lane >> 4) & 1) * 32 + (lane & 3) * 8 + (4 * hi + ((lane & 15) >> 2)) * 64;
        LAS unsigned char* vw = vb + lane * 16;
        const int bh = unit >> 7, qb = unit & 127, b = bh >> 4, h = bh & 15, qs = qb * 32, jd = qs >> 6;
        const bf16_t* Qw = Q + ((size_t)b * SEQ + qs + r32) * D + h * SBD + hi * 8;
        bf16x8 qr[4];
#pragma unroll
        for (int d0 = 0; d0 < 4; ++d0) qr[d0] = *(const bf16x8*)(Qw + d0 * 16);
        const bf16_t* Kh = K + (size_t)b * SEQ * D + h * SBD; const bf16_t* Vh = V + (size_t)b * SEQ * D + h * SBD;
        bf16x8 kc[8], kn[8]; u32x4 vn[8];
        int j = jd;
        sb_load_tile(kc, vn, Kh, Vh, j, lane);
#pragma unroll
        for (int w = 0; w < 8; ++w) *(LAS u32x4*)(vw + w * 1024) = vn[w];
        f32x16 o0 = {0.f, 0.f, 0.f, 0.f, 0.f, 0.f, 0.f, 0.f, 0.f, 0.f, 0.f, 0.f, 0.f, 0.f, 0.f, 0.f}, o1 = o0; float carry = 0.f;
        if (j > 0) sb_load_tile(kn, vn, Kh, Vh, j - 1, lane);
        sb_tile<true>(kc, qr, vp0, o0, o1, carry, (qs & 63) + r32 - 4 * hi, hi, m0);
        while (j > 0 && !__all(carry < -152.f)) {
#pragma unroll
            for (int w = 0; w < 8; ++w) *(LAS u32x4*)(vw + w * 1024) = vn[w];
#pragma unroll
            for (int i = 0; i < 8; ++i) kc[i] = kn[i];
            --j;
            if (j > 0) sb_load_tile(kn, vn, Kh, Vh, j - 1, lane);
            sb_tile<false>(kc, qr, vp0, o0, o1, carry, 0, hi, m0);
        }
        bf16_t* Ow = O + ((size_t)b * SEQ + qs + 4 * hi) * D + h * SBD + r32;
#pragma unroll
        for (int r = 0; r < 16; ++r) { const int q = (r & 3) + 8 * (r >> 2); const unsigned w0 = cvt_pk_bf16(o0[r], o1[r]);
            Ow[(size_t)q * D] = (bf16_t)(w0 & 0xffffu); Ow[(size_t)q * D + 32] = (bf16_t)(w0 >> 16); }
    }
}

#ifndef PROBE_SEL
#define PROBE_SEL -1
#endif
struct Probe { unsigned long long last, sel, tb; };
#if PROBE_SEL >= 0
#define PH_END(k) do { const unsigned long long now_ = __builtin_amdgcn_s_memrealtime(); if ((k) == PROBE_SEL) pr.sel += now_ - pr.last; pr.last = now_; } while (0)
#define GRID_BAR() do { pr.tb = __builtin_amdgcn_s_memrealtime(); xcd_barrier(bar); if (PROBE_SEL == 13) pr.sel += __builtin_amdgcn_s_memrealtime() - pr.tb; } while (0)
#else
#define PH_END(k) do { } while (0)
#define GRID_BAR() xcd_barrier(bar)
#endif
struct Args { const float* in[10]; float* out; unsigned char* ws; };
struct Ctx { LAS unsigned char* lds; unsigned char* ws; const float* const* in; float* out; int G, bx, gw, ngw, wave, lane, tid; };

template <int L> __device__ __forceinline__ void layer(const Ctx& c, const XcdBarrier& bar, Probe& pr) {
    LAS unsigned char* lds = c.lds; unsigned char* ws = c.ws; const int G = c.G, bx = c.bx;
    const float* x = c.in[0]; float* out = c.out;
    float* ssq = (float*)(ws + WS_SSQ); float* GN = (float*)(ws + WS_GN);
    bf16_t* hbf = (bf16_t*)(ws + WS_HBF); bf16_t* wmix = (bf16_t*)(ws + WS_WMIX); bf16_t* wmlp = (bf16_t*)(ws + WS_WMLP);
    const float* base = (L == 0) ? x : out;
    if constexpr ((L & 1) == 0) {
        bf16_t* Qb = (bf16_t*)(ws + WS_Q); bf16_t* Kb = (bf16_t*)(ws + WS_K); bf16_t* Vb = (bf16_t*)(ws + WS_V);
        { pg8::StdOrder S; S.init(M, 3 * D, G, bx, hbf, wmix, D, D); EpiQKV E{Qb, ssq};
          pg8::gemm_phase<EpiQKV, pg8::StdOrder, D, D, D, true>(lds, S, E); }
        GRID_BAR(); PH_END(1);
        sb_attn_mfma(Qb, Kb, Vb, Qb, lds, c.gw, c.ngw, c.wave, c.lane);
        GRID_BAR(); PH_END(2);
        convert_mlp(L, c.in, ws, lds, c.gw, c.ngw, c.wave, c.lane);
        { pg8::StdOrder S; S.init(M, D, G, bx, Qb, wmix + (size_t)3 * D * D, D, D); EpiRes E{base, out, hbf, ssq};
          pg8::gemm_phase<EpiRes, pg8::StdOrder, D, D, D, false>(lds, S, E); }
        GRID_BAR(); PH_END(3);
    } else {
        bf16_t* SQ = (bf16_t*)(ws + WS_SQ); bf16_t* VS = (bf16_t*)(ws + WS_VS); bf16_t* KN = (bf16_t*)(ws + WS_KN); bf16_t* Y = (bf16_t*)(ws + WS_Y);
        { pg8::StdOrder S; S.init(M, 2 * D, G, bx, hbf, wmix, D, D); EpiRetQK E{SQ, KN, ssq};
          pg8::gemm_phase<EpiRetQK, pg8::StdOrder, D, D, D, true>(lds, S, E); }
        { pg8::StdOrder S; S.init(2 * D, M, G, bx, wmix + (size_t)2 * D * D, hbf, D, D); EpiRetVt E{VS, ssq};
          pg8::gemm_phase<EpiRetVt, pg8::StdOrder, D, D, D, true>(lds, S, E); }
        GRID_BAR(); PH_END(4);
        { KVOrder S{G, bx, (const char*)VS, (const char*)SQ}; EpiKV E{VS};
          pg8::gemm_phase<EpiKV, KVOrder, 512, 512, 256, true>(lds, S, E); }
        { SOrder S{G, bx, (const char*)SQ, (const char*)KN}; EpiS E{SQ};
          pg8::gemm_phase<EpiS, SOrder, 512, 1024, 256, true>(lds, S, E); }
        GRID_BAR(); PH_END(5);
        ret_scan(VS, bx * NWAVES * 64 + c.tid, G * NWAVES * 64);
        GRID_BAR(); PH_END(6);
        { OOrder S{G, bx, (const char*)SQ, (const char*)VS}; EpiO E{SQ, KN, GN};
          pg8::gemm_phase<EpiO, OOrder, 512, 512, 512, true>(lds, S, E); }
        GRID_BAR(); PH_END(7);
        { pg8::StdOrder S; S.init(M, 2 * D, G, bx, hbf, wmix + (size_t)4 * D * D, D, D); EpiG E{SQ, KN, GN, ssq, Y};
          pg8::gemm_phase<EpiG, pg8::StdOrder, D, D, D, true>(lds, S, E); }
        GRID_BAR(); PH_END(8);
        convert_mlp(L, c.in, ws, lds, c.gw, c.ngw, c.wave, c.lane);
        { pg8::StdOrder S; S.init(M, D, G, bx, Y, wmix + (size_t)6 * D * D, 2 * D, 2 * D); EpiRes E{base, out, hbf, ssq};
          pg8::gemm_phase<EpiRes, pg8::StdOrder, 2 * D, 2 * D, 2 * D, false>(lds, S, E); }
        GRID_BAR(); PH_END(9);
    }
    bf16_t* U = (bf16_t*)(ws + WS_U);
    { pg8::StdOrder S; S.init(M, FF, G, bx, hbf, wmlp, D, D); EpiUp E{U, ssq};
      pg8::gemm_phase<EpiUp, pg8::StdOrder, D, D, D, true>(lds, S, E); }
    GRID_BAR(); PH_END(10);
    if constexpr (L + 1 < NLAYER) convert_mix(L + 1, c.in, ws, lds, c.gw, c.ngw, c.wave, c.lane);
    { pg8::StdOrder S; S.init(M, D, G, bx, U, wmlp + (size_t)FF * D, FF, FF); EpiRes E{out, out, hbf, ssq};
      pg8::gemm_phase<EpiRes, pg8::StdOrder, FF, FF, FF, false>(lds, S, E); }
    GRID_BAR(); PH_END(11);
}

__global__ void __launch_bounds__(NWAVES * 64, 2) trunk_fwd(Args args) {
    extern __shared__ __attribute__((aligned(16))) unsigned char lds_raw[];
    LAS unsigned char* lds = (LAS unsigned char*)lds_raw;
    volatile LAS unsigned* MISC = (volatile LAS unsigned*)(lds + MISC_OFF);
    const int tid = threadIdx.x, lane = tid & 63, wave = __builtin_amdgcn_readfirstlane(tid >> 6);
    const int G = gridDim.x, bx = blockIdx.x;
    const int gw = bx * NWAVES + wave, ngw = G * NWAVES;
    unsigned char* ws = args.ws;
    unsigned* ctl = (unsigned*)(ws + WS_CTL);
    for (int u = tid; u < (LDS_BYTES - LDSCTL_OFF) / 4; u += NWAVES * 64) ((LAS unsigned*)(lds + LDSCTL_OFF))[u] = 0u;
    __syncthreads();
    const XcdBarrier bar = xcd_barrier_post(ctl + 4096, MISC + 8);
    const Ctx c{lds, ws, args.in, args.out, G, bx, gw, ngw, wave, lane, tid};
    Probe pr{0ull, 0ull, 0ull};
#if PROBE_SEL >= 0
    pr.last = __builtin_amdgcn_s_memrealtime();
#endif

    p0_rows(args.in[0], (bf16_t*)(ws + WS_HBF), (float*)(ws + WS_SSQ), gw, ngw, lane);
    convert_mix(0, args.in, ws, lds, gw, ngw, wave, lane);
    GRID_BAR(); PH_END(0);
    layer<0>(c, bar, pr); layer<1>(c, bar, pr); layer<2>(c, bar, pr); layer<3>(c, bar, pr);
    { int lane_f = lane; asm volatile("" : "+v"(lane_f));
      final_rows(args.out, (const float*)(ws + WS_SSQ), args.in[9], gw, ngw, lane_f); }
#if PROBE_SEL >= 0
    PH_END(12);
    if (bx == 0 && tid == 0) { const unsigned long long t0 = __builtin_amdgcn_s_memrealtime(); while (__builtin_amdgcn_s_memrealtime() - t0 < 8ull * pr.sel) __builtin_amdgcn_s_sleep(8); }
#endif
}

extern "C" void kernel_launch(void* const* d_in, const int* in_sizes, int n_in, void* d_out, int out_size, void* d_ws, size_t ws_size, hipStream_t stream) {
    static int grid = 0;
    if (grid == 0) {
        if (n_in != 10 || in_sizes[0] != M * D || out_size != M * D || ws_size < WS_END) { fprintf(stderr, "kernel_launch: unexpected shapes / workspace (%d inputs, ws %zu < %zu)\n", n_in, ws_size, (size_t)WS_END); grid = -1; return; }
        int dev = 0, cus = 0, per_cu = 0;
        if (hipGetDevice(&dev) != hipSuccess || hipDeviceGetAttribute(&cus, hipDeviceAttributeMultiprocessorCount, dev) != hipSuccess) { grid = -1; return; }
        if (hipFuncSetAttribute((const void*)trunk_fwd, hipFuncAttributeMaxDynamicSharedMemorySize, LDS_BYTES) != hipSuccess) { fprintf(stderr, "kernel_launch: hipFuncSetAttribute failed\n"); grid = -1; return; }
        if (hipOccupancyMaxActiveBlocksPerMultiprocessor(&per_cu, (const void*)trunk_fwd, NWAVES * 64, LDS_BYTES) != hipSuccess || per_cu < 1) fprintf(stderr, "kernel_launch: occupancy query reports %d\n", per_cu);
        (void)hipGetLastError();
        grid = cus;
    }
    if (grid < 0) return;
    if (hipMemsetAsync((char*)d_ws + WS_CTL, 0, CTL_ZERO_BYTES, stream) != hipSuccess) return;
    Args a{};
    for (int i = 0; i < 10; ++i) a.in[i] = (const float*)d_in[i];
    a.out = (float*)d_out; a.ws = (unsigned char*)d_ws;
    hipLaunchKernelGGL(trunk_fwd, dim3(grid), dim3(NWAVES * 64), LDS_BYTES, stream, a);
}
```

```cpp
#include <hip/hip_runtime.h>
#include <cstdio>
#include <cstdint>

#define PG8_LAS __attribute__((address_space(3)))
#define GAS __attribute__((address_space(1)))
#define LAS __attribute__((address_space(3)))
typedef unsigned short bf16_t;
typedef short bf16x8 __attribute__((ext_vector_type(8)));
typedef float f32x4 __attribute__((ext_vector_type(4)));
typedef float f32x2 __attribute__((ext_vector_type(2)));
typedef unsigned u32x4 __attribute__((ext_vector_type(4)));
typedef unsigned u32x2 __attribute__((ext_vector_type(2)));

constexpr int BATCH = 4, SEQ = 4096, D = 1024, FF = 4096, NLAYER = 4;
constexpr int M = BATCH * SEQ;
constexpr int SBH = 16, SBD = 64;
constexpr int RH = 4, RDK = 256, RDV = 512, RC = 256, RNC = SEQ / RC;
constexpr int NPROB = BATCH * RH * RNC;
constexpr float RMS_EPS = 1e-6f, GN_EPS = 1e-6f;
constexpr float C2 = 0.18033688011112042f;
constexpr float L2B127 = 0.10462765653188542f;
constexpr float INV2PI = 0.15915494309189535f;
constexpr float LOG2E = 1.4426950408889634f;
__device__ __forceinline__ float lg2gamma(int h) { return h == 0 ? -0.04580368961312479f : (h == 1 ? -0.02272007650008353f : (h == 2 ? -0.011315313227834146f : -0.005646563141142063f)); }

constexpr size_t MiB = 1u << 20;
constexpr size_t WS_CTL = 0, CTL_ZERO_BYTES = 1 * MiB;
constexpr size_t WS_SSQ = 1 * MiB;
constexpr size_t WS_GN = 2 * MiB;
constexpr size_t WS_HBF = 6 * MiB;
constexpr size_t WS_WMIX = 38 * MiB;
constexpr size_t WS_SCR = 54 * MiB;
constexpr size_t WS_Q = WS_SCR, WS_K = WS_SCR + 32 * MiB, WS_V = WS_SCR + 64 * MiB;
constexpr size_t WS_SQ = WS_SCR;
constexpr size_t WS_VS = WS_SCR + 64 * MiB;
constexpr size_t WS_KN = WS_SCR + 192 * MiB;
constexpr size_t WS_Y = WS_VS;
constexpr size_t WS_U = WS_SCR;
constexpr size_t WS_WMLP = WS_SCR + 192 * MiB;
constexpr size_t WS_END = WS_SCR + 224 * MiB;
constexpr size_t SQ_P = 256 * 512, VS_P = 512 * 512;

constexpr int RING_BYTES = 131072, LDSCTL_OFF = RING_BYTES, MISC_OFF = LDSCTL_OFF + 320, LDS_BYTES = 147456;
constexpr int NWAVES = 8;

__device__ __forceinline__ unsigned cvt_pk_bf16(float lo, float hi) { unsigned r; asm volatile("v_cvt_pk_bf16_f32 %0, %1, %2" : "=v"(r) : "v"(lo), "v"(hi)); return r; }
__device__ __forceinline__ float bf_lo(unsigned w) { return __uint_as_float(w << 16); }
__device__ __forceinline__ float bf_hi(unsigned w) { return __uint_as_float(w & 0xffff0000u); }
__device__ __forceinline__ u32x4 pack8(f32x4 a, f32x4 b) { u32x4 w; w.x = cvt_pk_bf16(a[0], a[1]); w.y = cvt_pk_bf16(a[2], a[3]); w.z = cvt_pk_bf16(b[0], b[1]); w.w = cvt_pk_bf16(b[2], b[3]); return w; }
__device__ __forceinline__ float wave_sum(float v) {
#pragma unroll
    for (int o = 1; o < 64; o <<= 1) v += __shfl_xor(v, o);
    return v;
}
__device__ __forceinline__ float rinv_of(float ss) { return 1.0f / sqrtf(ss * (1.0f / D) + RMS_EPS); }
#define LDS_WAIT() asm volatile("s_waitcnt lgkmcnt(0)" ::: "memory")
#define VM_WAIT() asm volatile("s_waitcnt vmcnt(0)" ::: "memory")

namespace pg8 {
constexpr int BM = 256, BK = 64, HALF = 128, HTB = HALF * BK * 2, STAGE_BYTES = 8 * HTB, NXCD = 8, WGM = 8;
__host__ __device__ __forceinline__ int lds_byte(int r, int c) { const int st = (r >> 4) * 2 + (c >> 5), rr = r & 15, cc = c & 31, ob = rr * 64 + cc * 2; return st * 1024 + (ob ^ (((ob >> 9) & 1) << 5)); }
__host__ __device__ __forceinline__ void stage_rc(int b, int& R, int& C) { const int st = b / 1024, sb = b % 1024, swz = sb ^ (((sb >> 9) & 1) << 5); R = (st >> 1) * 16 + swz / 64; C = (st & 1) * 32 + (swz % 64) / 2; }
__host__ __device__ __forceinline__ int perm32(int rho) { const int n = rho >> 4, i = rho & 15; return 8 * (i >> 2) + 4 * n + (i & 3); }

struct Unit { int pm, pn, p; const char* a; const char* b; };

struct StdOrder {
    int nM, nN, nwg, G, c; const char* A; const char* B; size_t tA, tB;
    __device__ __forceinline__ void init(int Mr, int Nc, int G_, int c_, const void* A_, const void* B_, int lda, int ldb) { nM = Mr / BM; nN = Nc / BM; nwg = nM * nN; G = G_; c = c_; A = (const char*)A_; B = (const char*)B_; tA = (size_t)BM * lda * 2; tB = (size_t)BM * ldb * 2; }
    __device__ __forceinline__ bool next(int i, Unit& u) const {
        const long L = (long)i * G + c; if (L >= nwg) return false;
        int wgid = (int)L; { const int q = nwg / NXCD, r = nwg % NXCD, xcd = wgid % NXCD, off = wgid / NXCD; wgid = (xcd < r ? xcd * (q + 1) : r * (q + 1) + (xcd - r) * q) + off; }
        const int nig = WGM * nN, gid = wgid / nig, fm = gid * WGM, gsz = (nM - fm) < WGM ? (nM - fm) : WGM;
        u.pm = fm + ((wgid % nig) % gsz); u.pn = (wgid % nig) / gsz; u.p = 0; u.a = A + (size_t)u.pm * tA; u.b = B + (size_t)u.pn * tB; return true;
    }
};

template <class Epi, class Sched, int LDA, int LDB, int KD, bool ALIGN_EPI>
__device__ __forceinline__ void gemm_phase(PG8_LAS unsigned char* lds, const Sched& S, const Epi& E) {
    int tid = threadIdx.x; asm volatile("" : "+v"(tid));
    const int wid = __builtin_amdgcn_readfirstlane(tid >> 6), lane = tid & 63, wr = wid >> 2, wc = wid & 3, fr = lane & 15, fq = lane >> 4;
    constexpr int nt = KD / BK;
    static_assert(KD % 128 == 0 && KD >= 256, "K multiple of 128, >= 256");
    unsigned voffA[2], voffB[2];
#pragma unroll
    for (int i = 0; i < 2; ++i) { int R, C; stage_rc(tid * 16 + i * 8192, R, C); const int Rb = (R & ~31) + perm32(R & 31);
        voffA[i] = (unsigned)(R * LDA + C) * 2u; voffB[i] = (unsigned)(Rb * LDB + C) * 2u; }
    constexpr size_t kstep = (size_t)(BK * 2), hstepA = (size_t)HALF * LDA * 2, hstepB = (size_t)HALF * LDB * 2;
    const unsigned ldsw = (unsigned)wid * 1024u;
    const int aoff = lds_byte(wr * 64 + fr, fq * 8), boff = lds_byte(wc * 32 + fr, fq * 8);
#define PG8_SA(b, h) (((b) * 2 + (h)) * HTB)
#define PG8_SB(b, h) ((4 + (b) * 2 + (h)) * HTB)
#define PG8_STAGE(bufoff, gbase, voff) do { _Pragma("unroll") for (int _i = 0; _i < 2; ++_i) \
        __builtin_amdgcn_global_load_lds((const unsigned*)((const char*)(gbase) + (voff)[_i]), (PG8_LAS unsigned*)(lds + (bufoff) + ldsw + _i * 8192), 16, 0, 0); } while (0)
#define PG8_LDA(dst, b, h) do { _Pragma("unroll") for (int m = 0; m < 4; ++m) _Pragma("unroll") for (int k = 0; k < 2; ++k) dst[m][k] = *(const PG8_LAS bf16x8*)(lds + PG8_SA(b, h) + aoff + m * 2048 + k * 1024); } while (0)
#define PG8_LDB(dst, b, h) do { _Pragma("unroll") for (int n = 0; n < 2; ++n) _Pragma("unroll") for (int k = 0; k < 2; ++k) dst[n][k] = *(const PG8_LAS bf16x8*)(lds + PG8_SB(b, h) + boff + n * 2048 + k * 1024); } while (0)
#define PG8_MMA(ai, bj, At, Bt) do { __builtin_amdgcn_s_setprio(1); _Pragma("unroll") for (int m = 0; m < 4; ++m) _Pragma("unroll") for (int n = 0; n < 2; ++n) _Pragma("unroll") for (int k = 0; k < 2; ++k) \
        acc[ai][bj][m][n] = __builtin_amdgcn_mfma_f32_16x16x32_bf16(Bt[n][k], At[m][k], acc[ai][bj][m][n], 0, 0, 0); __builtin_amdgcn_s_setprio(0); } while (0)
#define PG8_WAIT_V(n) asm volatile("s_waitcnt vmcnt(" #n ")" ::: "memory")
#define PG8_WAIT_L(n) asm volatile("s_waitcnt lgkmcnt(" #n ")" ::: "memory")
#define PG8_BAR __builtin_amdgcn_s_barrier()
#define PG8_SCHED __builtin_amdgcn_sched_barrier(0)
    Unit cur, nxt; int ui = 0;
    if (!S.next(0, cur)) return;
    f32x4 acc[2][2][4][2];
#pragma unroll
    for (int a = 0; a < 2; ++a)
#pragma unroll
        for (int b = 0; b < 2; ++b)
#pragma unroll
            for (int m = 0; m < 4; ++m)
#pragma unroll
                for (int n = 0; n < 2; ++n) acc[a][b][m][n] = (f32x4){0.f, 0.f, 0.f, 0.f};
    bf16x8 At[4][2], B0[2][2], B1[2][2];
    const char* cA = cur.a; const char* cB = cur.b;
    PG8_STAGE(PG8_SB(0, 0), cB, voffB); PG8_STAGE(PG8_SB(0, 1), cB + hstepB, voffB); PG8_STAGE(PG8_SA(0, 0), cA, voffA); PG8_STAGE(PG8_SA(0, 1), cA + hstepA, voffA);
    if (wr == 1) PG8_BAR;
    PG8_WAIT_V(2); PG8_BAR;
    PG8_STAGE(PG8_SB(1, 0), cB + kstep, voffB); PG8_STAGE(PG8_SA(1, 0), cA + kstep, voffA); PG8_STAGE(PG8_SB(1, 1), cB + hstepB + kstep, voffB);
    PG8_WAIT_V(6); PG8_BAR;
    for (;;) {
        const bool has_next = S.next(ui + 1, nxt);
        const char* nA = has_next ? nxt.a : cA; const char* nB = has_next ? nxt.b : cB;
#pragma nounroll
        for (int t = 0; t < nt; t += 2) {
            const bool last = (t == nt - 2);
            const char* a1 = cA + (size_t)(t + 1) * kstep;
            const char* a2 = last ? nA : cA + (size_t)(t + 2) * kstep; const char* b2 = last ? nB : cB + (size_t)(t + 2) * kstep;
            const char* a3 = a2 + kstep; const char* b3 = b2 + kstep;
            PG8_LDB(B0, 0, 0); PG8_LDB(B1, 0, 1); PG8_SCHED; PG8_LDA(At, 0, 0); PG8_STAGE(PG8_SA(1, 1), a1 + hstepA, voffA);
            PG8_WAIT_V(8); PG8_WAIT_L(0); PG8_BAR; PG8_MMA(0, 0, At, B0); PG8_MMA(0, 1, At, B1); PG8_BAR; PG8_SCHED;
            PG8_LDA(At, 0, 1); PG8_STAGE(PG8_SB(0, 0), b2, voffB); PG8_STAGE(PG8_SB(0, 1), b2 + hstepB, voffB); PG8_STAGE(PG8_SA(0, 0), a2, voffA);
            PG8_WAIT_V(8); PG8_WAIT_L(0); PG8_BAR; PG8_MMA(1, 0, At, B0); PG8_MMA(1, 1, At, B1); PG8_BAR; PG8_SCHED;
            PG8_LDB(B0, 1, 0); PG8_LDB(B1, 1, 1); PG8_SCHED; PG8_LDA(At, 1, 0); PG8_STAGE(PG8_SA(0, 1), a2 + hstepA, voffA);
            PG8_WAIT_V(8); PG8_WAIT_L(0); PG8_BAR; PG8_MMA(0, 0, At, B0); PG8_MMA(0, 1, At, B1); PG8_BAR; PG8_SCHED;
            PG8_LDA(At, 1, 1); PG8_STAGE(PG8_SB(1, 0), b3, voffB); PG8_STAGE(PG8_SB(1, 1), b3 + hstepB, voffB); PG8_STAGE(PG8_SA(1, 0), a3, voffA);
            PG8_WAIT_V(8); PG8_WAIT_L(0); PG8_BAR; PG8_MMA(1, 0, At, B0); PG8_MMA(1, 1, At, B1); PG8_BAR; PG8_SCHED;
        }
        if constexpr (ALIGN_EPI) { if (wr == 0) PG8_BAR; }
        E(acc, cur, wr, wc, fr, fq);
        if (!has_next) break;
#pragma unroll
        for (int a = 0; a < 2; ++a)
#pragma unroll
            for (int b = 0; b < 2; ++b)
#pragma unroll
                for (int m = 0; m < 4; ++m)
#pragma unroll
                    for (int n = 0; n < 2; ++n) acc[a][b][m][n] = (f32x4){0.f, 0.f, 0.f, 0.f};
        cur = nxt; cA = nA; cB = nB; ++ui;
        if constexpr (ALIGN_EPI) { if (wr == 1) PG8_BAR; }
    }
    PG8_WAIT_V(0);
    if constexpr (!ALIGN_EPI) { if (wr == 0) PG8_BAR; }
    PG8_BAR;
#undef PG8_SA
#undef PG8_SB
#undef PG8_STAGE
#undef PG8_LDA
#undef PG8_LDB
#undef PG8_MMA
#undef PG8_WAIT_V
#undef PG8_WAIT_L
#undef PG8_BAR
#undef PG8_SCHED
}
typedef f32x4 Acc[2][2][4][2];
}
using pg8::Unit;

__device__ __forceinline__ void rinv_rows(const float* ssq, int rowbase, int fq, float (&ri)[2][4]) {
#pragma unroll
    for (int ai = 0; ai < 2; ++ai)
#pragma unroll
        for (int m = 0; m < 4; ++m) { const f32x4 v = *(const f32x4*)(ssq + (size_t)(rowbase + ai * 128 + m * 16) * 16 + fq * 4);
            float s = (v[0] + v[1]) + (v[2] + v[3]); s += __shfl_xor(s, 16); s += __shfl_xor(s, 32); ri[ai][m] = rinv_of(s); }
}
__device__ __forceinline__ void rinv_cols(const float* ssq, int colbase  , int fr, int lane, float (&rc)[2][8]) {
    const int tok = colbase + 128 * (fr >> 3) + (fr & 7); const f32x4* p = (const f32x4*)(ssq + (size_t)tok * 16);
    const f32x4 a = p[0], b = p[1], c = p[2], d = p[3];
    const float s = (((a[0] + a[1]) + (a[2] + a[3])) + ((b[0] + b[1]) + (b[2] + b[3]))) + (((c[0] + c[1]) + (c[2] + c[3])) + ((d[0] + d[1]) + (d[2] + d[3])));
    const float r = rinv_of(s);
#pragma unroll
    for (int bj = 0; bj < 2; ++bj)
#pragma unroll
        for (int q = 0; q < 8; ++q) rc[bj][q] = __shfl(r, (lane & 48) | (bj * 8 + q));
}
__device__ __forceinline__ void sincos_rev(float ang, float& sn, float& cs) { float rev = ang * INV2PI; rev = __builtin_amdgcn_fractf(rev); sn = __builtin_amdgcn_sinf(rev); cs = __builtin_amdgcn_cosf(rev); }

struct EpiQKV { static constexpr bool PERM = true; bf16_t* q; const float* ssq;
    __device__ __forceinline__ void operator()(const pg8::Acc& acc, const Unit& u, int wr, int wc, int fr, int fq) const {
        asm volatile("" : "+v"(fr), "+v"(fq));
        const int t = u.pn >> 2; bf16_t* base = q + (size_t)t * ((WS_K - WS_Q) / 2); const float sc = t == 0 ? C2 : 1.f;
        const int row0 = u.pm * 256 + wr * 64 + fr, col0 = (u.pn & 3) * 256 + wc * 32 + 8 * fq;
        float ri[2][4]; rinv_rows(ssq, row0, fq, ri);
#pragma unroll
        for (int ai = 0; ai < 2; ++ai)
#pragma unroll
            for (int m = 0; m < 4; ++m) { const float s = ri[ai][m] * sc; bf16_t* rowp = base + (size_t)(row0 + ai * 128 + m * 16) * D + col0;
#pragma unroll
                for (int bj = 0; bj < 2; ++bj) *(u32x4*)(rowp + bj * 128) = pack8(acc[ai][bj][m][0] * s, acc[ai][bj][m][1] * s); }
    }
};
struct EpiRes { static constexpr bool PERM = true; const float* base; float* out; bf16_t* hbf; float* ssq;
    __device__ __forceinline__ void operator()(const pg8::Acc& acc, const Unit& u, int wr, int wc, int fr, int fq) const {
        asm volatile("" : "+v"(fr), "+v"(fq));
        const int row0 = u.pm * 256 + wr * 64 + fr, col0 = u.pn * 256 + wc * 32 + 8 * fq;
        f32x4 nb[4];
        { const size_t off = (size_t)row0 * D + col0;
#pragma unroll
          for (int bj = 0; bj < 2; ++bj) { nb[2 * bj] = *(const f32x4*)(base + off + bj * 128); nb[2 * bj + 1] = *(const f32x4*)(base + off + bj * 128 + 4); } }
#pragma unroll
        for (int g = 0; g < 8; ++g) { const int ai = g >> 2, m = g & 3; const int row = row0 + ai * 128 + m * 16; const size_t off = (size_t)row * D + col0; float ss = 0.f;
            f32x4 cb[4];
#pragma unroll
            for (int k = 0; k < 4; ++k) cb[k] = nb[k];
            if (g < 7) { const size_t noff = (size_t)(row0 + ((g + 1) >> 2) * 128 + ((g + 1) & 3) * 16) * D + col0;
#pragma unroll
                for (int bj = 0; bj < 2; ++bj) { nb[2 * bj] = *(const f32x4*)(base + noff + bj * 128); nb[2 * bj + 1] = *(const f32x4*)(base + noff + bj * 128 + 4); } }
            asm volatile("" ::: "memory");
#pragma unroll
            for (int bj = 0; bj < 2; ++bj) { const f32x4 h0 = cb[2 * bj] + acc[ai][bj][m][0], h1 = cb[2 * bj + 1] + acc[ai][bj][m][1];
                *(f32x4*)(out + off + bj * 128) = h0; *(f32x4*)(out + off + bj * 128 + 4) = h1; *(u32x4*)(hbf + off + bj * 128) = pack8(h0, h1);
                ss += ((h0[0] * h0[0] + h0[1] * h0[1]) + (h0[2] * h0[2] + h0[3] * h0[3])) + ((h1[0] * h1[0] + h1[1] * h1[1]) + (h1[2] * h1[2] + h1[3] * h1[3])); }
            ss += __shfl_xor(ss, 16); ss += __shfl_xor(ss, 32); if (fq == 0) ssq[(size_t)row * 16 + u.pn * 4 + wc] = ss; }
    }
};
struct EpiUp { static constexpr bool PERM = true; bf16_t* uo; const float* ssq;
    __device__ __forceinline__ void operator()(const pg8::Acc& acc, const Unit& u, int wr, int wc, int fr, int fq) const {
        asm volatile("" : "+v"(fr), "+v"(fq));
        const int row0 = u.pm * 256 + wr * 64 + fr, col0 = u.pn * 256 + wc * 32 + 8 * fq;
        float ri[2][4]; rinv_rows(ssq, row0, fq, ri);
#pragma unroll
        for (int ai = 0; ai < 2; ++ai)
#pragma unroll
            for (int m = 0; m < 4; ++m) { const float s = ri[ai][m]; bf16_t* rowp = uo + (size_t)(row0 + ai * 128 + m * 16) * FF + col0;
#pragma unroll
                for (int bj = 0; bj < 2; ++bj) { f32x4 a = acc[ai][bj][m][0] * s, b = acc[ai][bj][m][1] * s;
#pragma unroll
                    for (int e = 0; e < 4; ++e) { const float x = fmaxf(a[e], 0.f), y = fmaxf(b[e], 0.f); a[e] = x * x; b[e] = y * y; }
                    *(u32x4*)(rowp + bj * 128) = pack8(a, b); } }
    }
};
struct EpiRetQK { static constexpr bool PERM = true; bf16_t* SQ; bf16_t* KN; const float* ssq;
    __device__ __forceinline__ void operator()(const pg8::Acc& acc, const Unit& u, int wr, int wc, int fr, int fq) const {
        asm volatile("" : "+v"(fr), "+v"(fq));
        const bool isq = u.pn < 4; const int h = u.pn & 3, b = u.pm >> 4, N = u.pm & 15, p = (b * 4 + h) * 16 + N;
        const int row0 = u.pm * 256 + wr * 64 + fr, i0 = wr * 64 + fr, cb = wc * 32 + 8 * fq; const float lg = lg2gamma(h);
        float ri[2][4]; rinv_rows(ssq, row0, fq, ri);
        float invf[8];
#pragma unroll
        for (int q = 0; q < 8; ++q) invf[q] = __builtin_amdgcn_exp2f(-(float)(cb + q) * L2B127);
#pragma unroll
        for (int ai = 0; ai < 2; ++ai)
#pragma unroll
            for (int m = 0; m < 4; ++m) { const int il = i0 + ai * 128 + m * 16; const float pos = (float)(N * 256 + il);
                const float s = ri[ai][m], sc = isq ? __builtin_amdgcn_exp2f(lg * (float)(il + 1)) : 0.0625f;
                f32x4 y1[2], y2[2];
#pragma unroll
                for (int n = 0; n < 2; ++n)
#pragma unroll
                    for (int e = 0; e < 4; ++e) { float sn, cs; sincos_rev(pos * invf[n * 4 + e], sn, cs); const float x1 = acc[ai][0][m][n][e] * s, x2 = acc[ai][1][m][n][e] * s;
                        y1[n][e] = (x1 * cs - x2 * sn) * sc; y2[n][e] = (x1 * sn + x2 * cs) * sc; }
                bf16_t* dst = isq ? SQ + (size_t)p * SQ_P + (size_t)il * 512 + 256 + cb : KN + (size_t)(row0 + ai * 128 + m * 16) * 1024 + h * 256 + cb;
                *(u32x4*)dst = pack8(y1[0], y1[1]); *(u32x4*)(dst + 128) = pack8(y2[0], y2[1]);
                if (!isq) {
                    const float kd = __builtin_amdgcn_exp2f(lg * (float)(255 - il)); bf16_t* tb = SQ + (size_t)p * SQ_P + (size_t)cb * 512 + il;
#pragma unroll
                    for (int n = 0; n < 2; ++n)
#pragma unroll
                        for (int e = 0; e < 4; e += 2) { const unsigned w1 = cvt_pk_bf16(y1[n][e] * kd, y1[n][e + 1] * kd), w2 = cvt_pk_bf16(y2[n][e] * kd, y2[n][e + 1] * kd); const int dq = n * 4 + e;
                            tb[(size_t)dq * 512] = (bf16_t)(w1 & 0xffffu); tb[(size_t)(dq + 1) * 512] = (bf16_t)(w1 >> 16);
                            tb[(size_t)(128 + dq) * 512] = (bf16_t)(w2 & 0xffffu); tb[(size_t)(129 + dq) * 512] = (bf16_t)(w2 >> 16); } }
                __builtin_amdgcn_sched_barrier(0); }
    }
};
struct EpiRetVt { static constexpr bool PERM = true; bf16_t* VS; const float* ssq;
    __device__ __forceinline__ void operator()(const pg8::Acc& acc, const Unit& u, int wr, int wc, int fr, int fq) const {
        asm volatile("" : "+v"(fr), "+v"(fq));
        const int lane = fq * 16 + fr; const int b = u.pn >> 4, N = u.pn & 15, jb = wc * 32 + 8 * fq;
        float rc[2][8]; rinv_cols(ssq, u.pn * 256 + jb, fr, lane, rc);
        const int h = u.pm >> 1, eh = u.pm & 1, p = (b * 4 + h) * 16 + N;
#pragma unroll
        for (int ai = 0; ai < 2; ++ai)
#pragma unroll
            for (int m = 0; m < 4; ++m) { const int e_row = eh * 256 + ai * 128 + wr * 64 + m * 16 + fr;
#pragma unroll
                for (int bj = 0; bj < 2; ++bj) { f32x4 a = acc[ai][bj][m][0], c = acc[ai][bj][m][1];
#pragma unroll
                    for (int e = 0; e < 4; ++e) { a[e] *= rc[bj][e]; c[e] *= rc[bj][4 + e]; }
                    *(u32x4*)(VS + (size_t)p * VS_P + (size_t)e_row * 512 + bj * 128 + jb) = pack8(a, c); } }
    }
};
struct EpiKV { static constexpr bool PERM = true; bf16_t* VS;
    __device__ __forceinline__ void operator()(const pg8::Acc& acc, const Unit& u, int wr, int wc, int fr, int fq) const {
        asm volatile("" : "+v"(fr), "+v"(fq));
        bf16_t* base = VS + (size_t)u.p * VS_P + 256 + wc * 32 + 8 * fq;
#pragma unroll
        for (int ai = 0; ai < 2; ++ai)
#pragma unroll
            for (int m = 0; m < 4; ++m) { const int e_row = u.pm * 256 + ai * 128 + wr * 64 + m * 16 + fr;
#pragma unroll
                for (int bj = 0; bj < 2; ++bj) *(u32x4*)(base + (size_t)e_row * 512 + bj * 128) = pack8(acc[ai][bj][m][0], acc[ai][bj][m][1]); }
    }
};
struct EpiS { static constexpr bool PERM = true; bf16_t* SQ;
    __device__ __forceinline__ void operator()(const pg8::Acc& acc, const Unit& u, int wr, int wc, int fr, int fq) const {
        asm volatile("" : "+v"(fr), "+v"(fq));
        const int h = (u.p >> 4) & 3, jb = wc * 32 + 8 * fq; const float lg = lg2gamma(h);
        float gi[2][8];
#pragma unroll
        for (int bj = 0; bj < 2; ++bj)
#pragma unroll
            for (int q = 0; q < 8; ++q) gi[bj][q] = __builtin_amdgcn_exp2f(-lg * (float)(bj * 128 + jb + q + 1));
#pragma unroll
        for (int ai = 0; ai < 2; ++ai)
#pragma unroll
            for (int m = 0; m < 4; ++m) { const int i = ai * 128 + wr * 64 + m * 16 + fr;
#pragma unroll
                for (int bj = 0; bj < 2; ++bj) { f32x4 a = acc[ai][bj][m][0], c = acc[ai][bj][m][1];
#pragma unroll
                    for (int e = 0; e < 4; ++e) { const int d0 = i - (bj * 128 + jb + e);
                        a[e] = __uint_as_float(__float_as_uint(a[e] * gi[bj][e]) & ~(unsigned)(d0 >> 31)); c[e] = __uint_as_float(__float_as_uint(c[e] * gi[bj][4 + e]) & ~(unsigned)((d0 - 4) >> 31)); }
                    *(u32x4*)(SQ + (size_t)u.p * SQ_P + (size_t)i * 512 + bj * 128 + jb) = pack8(a, c); } __builtin_amdgcn_sched_barrier(0); }
    }
};
struct EpiO { static constexpr bool PERM = true; bf16_t* SQ; bf16_t* OH0; float* GN;
    __device__ __forceinline__ void operator()(const pg8::Acc& acc, const Unit& u, int wr, int wc, int fr, int fq) const {
        asm volatile("" : "+v"(fr), "+v"(fq));
        const int bh = u.p >> 4, N = u.p & 15, b = bh >> 2, h = bh & 3, cb = wc * 32 + 8 * fq;
        bf16_t* ob = u.pn == 0 ? OH0 + (size_t)u.p * 65536 : SQ + (size_t)u.p * SQ_P; const int pitch = u.pn == 0 ? 256 : 512;
#pragma unroll
        for (int ai = 0; ai < 2; ++ai)
#pragma unroll
            for (int m = 0; m < 4; ++m) { const int i = ai * 128 + wr * 64 + m * 16 + fr; float s = 0.f, q = 0.f;
#pragma unroll
                for (int bj = 0; bj < 2; ++bj) { const f32x4 a = acc[ai][bj][m][0], c = acc[ai][bj][m][1];
                    s += ((a[0] + a[1]) + (a[2] + a[3])) + ((c[0] + c[1]) + (c[2] + c[3]));
                    q += ((a[0] * a[0] + a[1] * a[1]) + (a[2] * a[2] + a[3] * a[3])) + ((c[0] * c[0] + c[1] * c[1]) + (c[2] * c[2] + c[3] * c[3]));
                    *(u32x4*)(ob + (size_t)i * pitch + bj * 128 + cb) = pack8(a, c); }
                s += __shfl_xor(s, 16); s += __shfl_xor(s, 32); q += __shfl_xor(q, 16); q += __shfl_xor(q, 32);
                if (fq == 0) { const size_t tok = (size_t)b * SEQ + N * 256 + i; *(f32x2*)(GN + (tok * 4 + h) * 16 + (u.pn * 4 + wc) * 2) = (f32x2){s, q}; } }
    }
};
struct EpiG { static constexpr bool PERM = true; const bf16_t* SQ; const bf16_t* OH0; const float* GN; const float* ssq; bf16_t* Y;
    __device__ __forceinline__ void operator()(const pg8::Acc& acc, const Unit& u, int wr, int wc, int fr, int fq) const {
        asm volatile("" : "+v"(fr), "+v"(fq));
        const int b = u.pm >> 4, N = u.pm & 15, h = u.pn >> 1, eh = u.pn & 1, p = (b * 4 + h) * 16 + N, cb = wc * 32 + 8 * fq;
        const int row0 = u.pm * 256 + wr * 64 + fr, i0 = wr * 64 + fr;
        float ri[2][4]; rinv_rows(ssq, row0, fq, ri);
        const bf16_t* ob = (eh == 0 ? OH0 + (size_t)p * 65536 : SQ + (size_t)p * SQ_P) + cb; const int pitch = eh == 0 ? 256 : 512;
        const float* gnb = GN + ((size_t)row0 * 4 + h) * 16 + fq * 4;
        u32x4 no[2]; f32x4 nst;
        no[0] = *(const u32x4*)(ob + (size_t)i0 * pitch); no[1] = *(const u32x4*)(ob + (size_t)i0 * pitch + 128); nst = *(const f32x4*)gnb;
#pragma unroll
        for (int g = 0; g < 8; ++g) { const int ai = g >> 2, m = g & 3; const size_t tok = (size_t)row0 + ai * 128 + m * 16;
            const u32x4 co[2] = {no[0], no[1]}; const f32x4 st = nst;
            if (g < 7) { const int r1 = ((g + 1) >> 2) * 128 + ((g + 1) & 3) * 16;
                no[0] = *(const u32x4*)(ob + (size_t)(i0 + r1) * pitch); no[1] = *(const u32x4*)(ob + (size_t)(i0 + r1) * pitch + 128); nst = *(const f32x4*)(gnb + (size_t)r1 * 64); }
            asm volatile("" ::: "memory");
            float s = st[0] + st[2], q = st[1] + st[3];
            s += __shfl_xor(s, 16); s += __shfl_xor(s, 32); q += __shfl_xor(q, 16); q += __shfl_xor(q, 32);
            const float mu = s * (1.0f / RDV), var = fmaxf(q * (1.0f / RDV) - mu * mu, 0.f), rstd = 1.0f / sqrtf(var + GN_EPS), rr = ri[ai][m];
#pragma unroll
            for (int bj = 0; bj < 2; ++bj) { const u32x4 ow = co[bj]; f32x4 a = acc[ai][bj][m][0] * rr, c = acc[ai][bj][m][1] * rr;
                const float o8[8] = {bf_lo(ow.x), bf_hi(ow.x), bf_lo(ow.y), bf_hi(ow.y), bf_lo(ow.z), bf_hi(ow.z), bf_lo(ow.w), bf_hi(ow.w)};
#pragma unroll
                for (int e = 0; e < 4; ++e) { const float g0 = a[e], g1 = c[e];
                    a[e] = g0 * __builtin_amdgcn_rcpf(1.f + __builtin_amdgcn_exp2f(-g0 * LOG2E)) * ((o8[e] - mu) * rstd);
                    c[e] = g1 * __builtin_amdgcn_rcpf(1.f + __builtin_amdgcn_exp2f(-g1 * LOG2E)) * ((o8[4 + e] - mu) * rstd); }
                *(u32x4*)(Y + tok * 2048 + h * 512 + eh * 256 + bj * 128 + cb) = pack8(a, c); } }
    }
};

struct KVOrder { int G, c; const char* VS; const char* SQ;
    __device__ __forceinline__ bool next(int i, Unit& u) const { const int p = c + (i >> 1) * G; if (p >= NPROB) return false; u.p = p; u.pm = i & 1; u.pn = 0;
        u.a = VS + (size_t)p * VS_P * 2 + (size_t)u.pm * 256 * 512 * 2; u.b = SQ + (size_t)p * SQ_P * 2; return true; } };
struct SOrder { int G, c; const char* SQ; const char* KN;
    __device__ __forceinline__ bool next(int i, Unit& u) const { const int p = c + i * G; if (p >= NPROB) return false; u.p = p; u.pm = 0; u.pn = 0;
        const int bh = p >> 4, N = p & 15, b = bh >> 2, h = bh & 3; u.a = SQ + (size_t)p * SQ_P * 2 + 512; u.b = KN + ((size_t)(b * SEQ + N * 256) * 1024 + h * 256) * 2; return true; } };
struct OOrder { int G, c; const char* SQ; const char* VS;
    __device__ __forceinline__ bool next(int i, Unit& u) const { const int p = c + (i >> 1) * G; if (p >= NPROB) return false; u.p = p; u.pm = 0; u.pn = i & 1;
        u.a = SQ + (size_t)p * SQ_P * 2; u.b = VS + (size_t)p * VS_P * 2 + (size_t)u.pn * 256 * 512 * 2; return true; } };

#define XB_TMO      128
#define XB_XCNT(j)  (256  + 64 * (j))
#define XB_XSUB(j)  (1280 + 64 * (j))
#define XB_XGEN(j)  (2304 + 64 * (j))
#define XB_TOP      3328
#define XB_TOPGEN   3392
#define XCD_BAR_WORDS 3456
#define XB_SPIN_CAP (1u << 18)
__device__ __forceinline__ unsigned xb_ld(unsigned* p)              { return __hip_atomic_load(p, __ATOMIC_RELAXED, __HIP_MEMORY_SCOPE_AGENT); }
__device__ __forceinline__ unsigned xb_add(unsigned* p, unsigned v) { return __hip_atomic_fetch_add(p, v, __ATOMIC_RELAXED, __HIP_MEMORY_SCOPE_AGENT); }
__device__ __forceinline__ unsigned xb_xcc_id() { return (unsigned)__builtin_amdgcn_s_getreg((3 << 11) | 20) & 0xFu; }
#define XB_SPIN(cond, bar) do { unsigned _sp = 0; while (cond) { __builtin_amdgcn_s_sleep(1); \
    if ((++_sp & 255u) == 0u) { if (xb_ld(&(bar)[XB_TMO])) break; if (_sp > XB_SPIN_CAP) { atomicAdd(&(bar)[XB_TMO], 1u); break; } } } } while (0)
struct XcdBarrier { unsigned* bar; unsigned x; volatile LAS unsigned* st; };
__device__ __forceinline__ XcdBarrier xcd_barrier_post(unsigned* bar, volatile LAS unsigned* st) {
    XcdBarrier b; b.bar = bar; b.x = xb_xcc_id(); b.st = st;
    if (threadIdx.x == 0) (void)xb_add(&bar[XB_XCNT(b.x)], 1u);
    return b;
}
__device__ __forceinline__ void xcd_barrier_complete(unsigned* bar, unsigned x, unsigned& nloc, unsigned& nx) {
    const unsigned G = gridDim.x * gridDim.y * gridDim.z;
    unsigned sum, cnt, mine, sp = 0u;
    for (;;) {
        sum = 0u; cnt = 0u; mine = 0u;
#pragma unroll
        for (unsigned j = 0; j < 16; ++j) { const unsigned c = xb_ld(&bar[XB_XCNT(j)]); sum += c; cnt += (c > 0u) ? 1u : 0u; mine = (j == x) ? c : mine; }
        if (sum == G) break;
        __builtin_amdgcn_s_sleep(1);
        if ((++sp & 255u) == 0u) { if (xb_ld(&bar[XB_TMO])) break; if (sp > XB_SPIN_CAP) { atomicAdd(&bar[XB_TMO], 1u); break; } }
    }
    nloc = mine > 0u ? mine : 1u; nx = cnt > 0u ? cnt : 1u;
}
__device__ __forceinline__ void xcd_barrier(const XcdBarrier& b) {
    asm volatile("s_waitcnt vmcnt(0)" ::: "memory");
    __syncthreads();
    if (threadIdx.x == 0) {
        unsigned* bar = b.bar;
        __builtin_amdgcn_s_waitcnt(0);
        unsigned nloc = b.st[0], nx = b.st[1];
        if (nloc == 0u) { xcd_barrier_complete(bar, b.x, nloc, nx); b.st[0] = nloc; b.st[1] = nx; }
        const unsigned old = xb_add(&bar[XB_XSUB(b.x)], 1u);
        const unsigned gen = old / nloc;
        if (old + 1u == (gen + 1u) * nloc) {
            __builtin_amdgcn_fence(__ATOMIC_RELEASE, "agent");
            asm volatile("s_waitcnt vmcnt(0)" ::: "memory");
            const unsigned og = xb_add(&bar[XB_TOP], 1u);
            const unsigned tg = og / nx;
            if (og + 1u == (tg + 1u) * nx) xb_add(&bar[XB_TOPGEN], 1u);
            else XB_SPIN(xb_ld(&bar[XB_TOPGEN]) == tg, bar);
            __builtin_amdgcn_fence(__ATOMIC_ACQUIRE, "agent");
            xb_add(&bar[XB_XGEN(b.x)], 1u);
            asm volatile("s_waitcnt vmcnt(0)" ::: "memory");
        } else {
            XB_SPIN(xb_ld(&bar[XB_XGEN(b.x)]) == gen, bar);
            __builtin_amdgcn_fence(__ATOMIC_ACQUIRE, "agent");
            asm volatile("s_waitcnt vmcnt(0)" ::: "memory");
        }
    }
    __syncthreads();
}

__device__ __forceinline__ void transpose_item(const float* W, const float* g, int K, int N, bf16_t* WT, LAS float* scr, int item, int lane) {
    const int nblk = N / 32, kb = item / nblk, nb = item % nblk, k0 = 64 * kb, n0 = 32 * nb;
    float wv[32];
#pragma unroll
    for (int i = 0; i < 32; ++i) { const int kk = 2 * i + (lane >> 5); wv[i] = W[(size_t)(k0 + kk) * N + n0 + (lane & 31)]; }
    if (g) {
#pragma unroll
        for (int i = 0; i < 32; ++i) wv[i] *= g[k0 + 2 * i + (lane >> 5)]; }
#pragma unroll
    for (int i = 0; i < 32; ++i) scr[(2 * i + (lane >> 5)) * 33 + (lane & 31)] = wv[i];
    LDS_WAIT(); asm volatile("" ::: "memory");
    const int c = lane & 7;
#pragma unroll
    for (int j = 0; j < 4; ++j) { const int n = (lane >> 3) + 8 * j; const LAS float* s = scr + (8 * c) * 33 + n;
        u32x4 o; o.x = cvt_pk_bf16(s[0 * 33], s[1 * 33]); o.y = cvt_pk_bf16(s[2 * 33], s[3 * 33]); o.z = cvt_pk_bf16(s[4 * 33], s[5 * 33]); o.w = cvt_pk_bf16(s[6 * 33], s[7 * 33]);
        *(u32x4*)(WT + (size_t)(n0 + n) * K + k0 + 8 * c) = o; }
    LDS_WAIT(); asm volatile("" ::: "memory");
}
__device__ __forceinline__ void convert_pair(const float* W0, const float* g0, int K0, int N0, bf16_t* T0, const float* W1, const float* g1, int K1, int N1, bf16_t* T1, LAS unsigned char* lds, int gw, int ngw, int wave, int lane) {
    LAS float* scr = (LAS float*)(lds + wave * 16384);
    const int I0 = (K0 / 64) * (N0 / 32), I1 = (K1 / 64) * (N1 / 32);
    for (int it = gw; it < I0 + I1; it += ngw) { if (it < I0) transpose_item(W0, g0, K0, N0, T0, scr, it, lane); else transpose_item(W1, g1, K1, N1, T1, scr, it - I0, lane); }
    __syncthreads();
}
__device__ __forceinline__ void convert_mix(int L, const float* const* in, unsigned char* ws, LAS unsigned char* lds, int gw, int ngw, int wave, int lane) {
    const int i = L >> 1; const float* g = in[5] + (size_t)L * D; bf16_t* T = (bf16_t*)(ws + WS_WMIX);
    if ((L & 1) == 0) convert_pair(in[1] + (size_t)i * D * 3 * D, g, D, 3 * D, T, in[2] + (size_t)i * D * D, nullptr, D, D, T + (size_t)3 * D * D, lds, gw, ngw, wave, lane);
    else convert_pair(in[3] + (size_t)i * D * 6 * D, g, D, 6 * D, T, in[4] + (size_t)i * 2 * D * D, nullptr, 2 * D, D, T + (size_t)6 * D * D, lds, gw, ngw, wave, lane);
}
__device__ __forceinline__ void convert_mlp(int L, const float* const* in, unsigned char* ws, LAS unsigned char* lds, int gw, int ngw, int wave, int lane) {
    bf16_t* T = (bf16_t*)(ws + WS_WMLP);
    convert_pair(in[7] + (size_t)L * D * FF, in[6] + (size_t)L * D, D, FF, T, in[8] + (size_t)L * FF * D, nullptr, FF, D, T + (size_t)FF * D, lds, gw, ngw, wave, lane);
}
__device__ __forceinline__ void p0_rows(const float* x, bf16_t* hbf, float* ssq, int gw, int ngw, int lane) {
    for (int m = gw; m < M / 2; m += ngw) { f32x4 v[2][4]; float s[2];
#pragma unroll
        for (int r = 0; r < 2; ++r) { const f32x4* xr = (const f32x4*)(x + (size_t)(2 * m + r) * D) + lane;
#pragma unroll
            for (int j = 0; j < 4; ++j) v[r][j] = xr[64 * j]; }
#pragma unroll
        for (int r = 0; r < 2; ++r) { s[r] = 0.f;
#pragma unroll
            for (int j = 0; j < 4; ++j) s[r] += (v[r][j][0] * v[r][j][0] + v[r][j][1] * v[r][j][1]) + (v[r][j][2] * v[r][j][2] + v[r][j][3] * v[r][j][3]);
            s[r] = wave_sum(s[r]);
            u32x2* o8 = (u32x2*)(hbf + (size_t)(2 * m + r) * D) + lane;
#pragma unroll
            for (int j = 0; j < 4; ++j) { u32x2 w; w.x = cvt_pk_bf16(v[r][j][0], v[r][j][1]); w.y = cvt_pk_bf16(v[r][j][2], v[r][j][3]); o8[64 * j] = w; }
            if (lane < 16) ssq[(size_t)(2 * m + r) * 16 + lane] = lane == 0 ? s[r] : 0.f; } }
}
__device__ __forceinline__ void final_rows(float* out, const float* ssq, const float* gf, int gw, int ngw, int lane) {
    const f32x4* gr = (const f32x4*)gf + lane; f32x4 gv[4];
#pragma unroll
    for (int j = 0; j < 4; ++j) gv[j] = gr[64 * j];
    for (int m = gw; m < M / 2; m += ngw) { f32x4 v[2][4]; float s[2];
#pragma unroll
        for (int r = 0; r < 2; ++r) { s[r] = ssq[(size_t)(2 * m + r) * 16 + (lane & 15)]; const f32x4* xr = (const f32x4*)(out + (size_t)(2 * m + r) * D) + lane;
#pragma unroll
            for (int j = 0; j < 4; ++j) v[r][j] = xr[64 * j]; }
#pragma unroll
        for (int r = 0; r < 2; ++r) { float t = s[r]; t += __shfl_xor(t, 1); t += __shfl_xor(t, 2); t += __shfl_xor(t, 4); t += __shfl_xor(t, 8);
            const float rr = rinv_of(t); f32x4* xr = (f32x4*)(out + (size_t)(2 * m + r) * D) + lane;
#pragma unroll
            for (int j = 0; j < 4; ++j) xr[64 * j] = v[r][j] * rr * gv[j]; } }
}
__device__ __forceinline__ void ret_scan(bf16_t* VS, int gtid, int gthreads) {
    for (int g = gtid; g < BATCH * RH * RDV * 32; g += gthreads) { const int bh = g >> 14, rem = g & 16383, e = rem >> 5, dg = rem & 31, h = bh & 3;
        const float dec = __builtin_amdgcn_exp2f(256.f * lg2gamma(h));
        bf16_t* p = VS + (size_t)bh * 16 * VS_P + (size_t)e * 512 + 256 + dg * 8; float st[8];
#pragma unroll
        for (int k = 0; k < 8; ++k) st[k] = 0.f;
        u32x4 w[16];
#pragma unroll
        for (int N = 0; N < 16; ++N) w[N] = *(const u32x4*)(p + (size_t)N * VS_P);
#pragma unroll
        for (int N = 0; N < 16; ++N) { u32x4 o; o.x = cvt_pk_bf16(st[0], st[1]); o.y = cvt_pk_bf16(st[2], st[3]); o.z = cvt_pk_bf16(st[4], st[5]); o.w = cvt_pk_bf16(st[6], st[7]);
            *(u32x4*)(p + (size_t)N * VS_P) = o;
            st[0] = dec * st[0] + bf_lo(w[N].x); st[1] = dec * st[1] + bf_hi(w[N].x); st[2] = dec * st[2] + bf_lo(w[N].y); st[3] = dec * st[3] + bf_hi(w[N].y);
            st[4] = dec * st[4] + bf_lo(w[N].z); st[5] = dec * st[5] + bf_hi(w[N].z); st[6] = dec * st[6] + bf_lo(w[N].w); st[7] = dec * st[7] + bf_hi(w[N].w); } }
}
__device__ __forceinline__ void sb_attn_simple(const bf16_t* Q, const bf16_t* K, const bf16_t* V, bf16_t* O, int gw, int ngw, int lane) {
    for (int task = gw; task < BATCH * SBH * (SEQ / 64); task += ngw) {
        const int bh = task >> 6, qb = task & 63, b = bh >> 4, h = bh & 15, q0 = qb * 64, t = q0 + lane;
        const size_t rowoff = ((size_t)b * SEQ + t) * D + h * SBD;
        float q[64], o[64];
#pragma unroll
        for (int i = 0; i < 8; ++i) { const u32x4 w = *(const u32x4*)(Q + rowoff + i * 8); q[8 * i + 0] = bf_lo(w.x); q[8 * i + 1] = bf_hi(w.x); q[8 * i + 2] = bf_lo(w.y); q[8 * i + 3] = bf_hi(w.y);
            q[8 * i + 4] = bf_lo(w.z); q[8 * i + 5] = bf_hi(w.z); q[8 * i + 6] = bf_lo(w.w); q[8 * i + 7] = bf_hi(w.w); }
#pragma unroll
        for (int i = 0; i < 64; ++i) o[i] = 0.f;
        float carry = 0.f;
        const bf16_t* Kb = K + (size_t)b * SEQ * D + h * SBD; const bf16_t* Vb = V + (size_t)b * SEQ * D + h * SBD;
        for (int s = q0 + 62; s >= 0; --s) {
            const u32x4* kr = (const u32x4*)(Kb + (size_t)s * D); float z0 = 0.f, z1 = 0.f;
#pragma unroll
            for (int i = 0; i < 8; ++i) { const u32x4 w = kr[i];
                z0 += q[8 * i + 0] * bf_lo(w.x); z1 += q[8 * i + 1] * bf_hi(w.x); z0 += q[8 * i + 2] * bf_lo(w.y); z1 += q[8 * i + 3] * bf_hi(w.y);
                z0 += q[8 * i + 4] * bf_lo(w.z); z1 += q[8 * i + 5] * bf_hi(w.z); z0 += q[8 * i + 6] * bf_lo(w.w); z1 += q[8 * i + 7] * bf_hi(w.w); }
            const float z = z0 + z1;
            const float l = __builtin_amdgcn_logf(1.f + __builtin_amdgcn_exp2f(-fabsf(z)));
            const float lk = -(fmaxf(z, 0.f) + l);
            const bool valid = s < t;
            const float a = valid ? __builtin_amdgcn_exp2f((z + lk) + carry) : 0.f;
            carry += valid ? lk : 0.f;
            const u32x4* vr = (const u32x4*)(Vb + (size_t)s * D);
#pragma unroll
            for (int i = 0; i < 8; ++i) { const u32x4 w = vr[i];
                o[8 * i + 0] += a * bf_lo(w.x); o[8 * i + 1] += a * bf_hi(w.x); o[8 * i + 2] += a * bf_lo(w.y); o[8 * i + 3] += a * bf_hi(w.y);
                o[8 * i + 4] += a * bf_lo(w.z); o[8 * i + 5] += a * bf_hi(w.z); o[8 * i + 6] += a * bf_lo(w.w); o[8 * i + 7] += a * bf_hi(w.w); }
            if (__all(carry < -152.f)) break;
        }
#pragma unroll
        for (int i = 0; i < 8; ++i) { u32x4 w; w.x = cvt_pk_bf16(o[8 * i + 0], o[8 * i + 1]); w.y = cvt_pk_bf16(o[8 * i + 2], o[8 * i + 3]); w.z = cvt_pk_bf16(o[8 * i + 4], o[8 * i + 5]); w.w = cvt_pk_bf16(o[8 * i + 6], o[8 * i + 7]);
            *(u32x4*)(O + rowoff + i * 8) = w; }
    }
}


typedef float f32x16 __attribute__((ext_vector_type(16)));
typedef short v4i16_t __attribute__((ext_vector_type(4)));
__device__ __forceinline__ v4i16_t vtr(const LAS unsigned char* p) { return __builtin_amdgcn_ds_read_tr16_b64_v4i16((LAS v4i16_t*)p); }
__device__ __forceinline__ float lane_partner(float mine) {
    const unsigned m = __float_as_uint(mine); const auto rr = __builtin_amdgcn_permlane32_swap(m, m, false, false); return __uint_as_float(rr[0] ^ rr[1] ^ m);
}
template <bool DIAG> __device__ __forceinline__ void sb_tile_math(float (&zz)[32], float& carry, int qlim, int hi, float m0) {
    float lk[32];
#pragma unroll
    for (int n = 0; n < 32; ++n) { const float z = zz[n];
        const float l = __builtin_amdgcn_logf(1.f + __builtin_amdgcn_exp2f(-fabsf(z)));
        float k = -(fmaxf(z, 0.f) + l), s = z + k;
        if (DIAG) { const bool v = ((n & 3) + 8 * ((n & 15) >> 2) + 32 * (n >> 4)) < qlim; k = v ? k : 0.f; s = v ? s : -INFINITY; }
        lk[n] = k; zz[n] = s; }
    float W = 0.f, off[8];
#pragma unroll
    for (int i = 7; i >= 0; --i) { const float t = ((lk[4 * i + 3] + lk[4 * i + 2]) + lk[4 * i + 1]) + lk[4 * i]; const float other = lane_partner(t); off[i] = carry + (W + m0 * other); W += t + other; }
    carry += W;
#pragma unroll
    for (int i = 0; i < 8; ++i) { const float bs = off[i], a = lk[4 * i + 3], b = a + lk[4 * i + 2], c = b + lk[4 * i + 1];
        zz[4 * i + 3] = __builtin_amdgcn_exp2f(zz[4 * i + 3] + bs); zz[4 * i + 2] = __builtin_amdgcn_exp2f(zz[4 * i + 2] + (bs + a));
        zz[4 * i + 1] = __builtin_amdgcn_exp2f(zz[4 * i + 1] + (bs + b)); zz[4 * i] = __builtin_amdgcn_exp2f(zz[4 * i] + (bs + c)); }
}
__device__ __forceinline__ void sb_load_tile(bf16x8 (&kf)[8], u32x4 (&vv)[8], const bf16_t* Kh, const bf16_t* Vh, int j, int lane) {
    const int r32 = lane & 31, hi = lane >> 5;
    const bf16_t* kp = Kh + (size_t)(64 * j + r32) * D + 8 * hi;
#pragma unroll
    for (int d0 = 0; d0 < 4; ++d0) { kf[2 * d0] = *(const bf16x8*)(kp + 16 * d0); kf[2 * d0 + 1] = *(const bf16x8*)(kp + (size_t)32 * D + 16 * d0); }
    const bf16_t* vp = Vh + (size_t)(64 * j + (lane >> 2)) * D + (lane & 3) * 8;
#pragma unroll
    for (int w = 0; w < 8; ++w) vv[w] = *(const u32x4*)(vp + (size_t)(16 * (w & 3)) * D + (w >> 2) * 32);
}
template <bool DIAG> __device__ __forceinline__ void sb_tile(const bf16x8 (&kf)[8], const bf16x8 (&qr)[4], const LAS unsigned char* vp0, f32x16& o0, f32x16& o1, float& carry, int qlim, int hi, float m0) {
    f32x16 p0 = {0.f, 0.f, 0.f, 0.f, 0.f, 0.f, 0.f, 0.f, 0.f, 0.f, 0.f, 0.f, 0.f, 0.f, 0.f, 0.f}, p1 = p0;
#pragma unroll
    for (int d0 = 0; d0 < 4; ++d0) { p0 = __builtin_amdgcn_mfma_f32_32x32x16_bf16(kf[2 * d0], qr[d0], p0, 0, 0, 0); p1 = __builtin_amdgcn_mfma_f32_32x32x16_bf16(kf[2 * d0 + 1], qr[d0], p1, 0, 0, 0); }
    float zz[32];
#pragma unroll
    for (int r = 0; r < 16; ++r) { zz[r] = p0[r]; zz[16 + r] = p1[r]; }
    sb_tile_math<DIAG>(zz, carry, qlim, hi, m0);
    u32x4 pw[4];
#pragma unroll
    for (int k = 0; k < 4; ++k) { pw[k].x = cvt_pk_bf16(zz[8 * k + 0], zz[8 * k + 1]); pw[k].y = cvt_pk_bf16(zz[8 * k + 2], zz[8 * k + 3]); pw[k].z = cvt_pk_bf16(zz[8 * k + 4], zz[8 * k + 5]); pw[k].w = cvt_pk_bf16(zz[8 * k + 6], zz[8 * k + 7]); }
#pragma unroll
    for (int d0 = 0; d0 < 2; ++d0)
#pragma unroll
        for (int ks = 0; ks < 4; ++ks) { const v4i16_t lo = vtr(vp0 + d0 * 4096 + ks * 1024), hh = vtr(vp0 + d0 * 4096 + ks * 1024 + 512);
            const bf16x8 vf = (bf16x8){lo[0], lo[1], lo[2], lo[3], hh[0], hh[1], hh[2], hh[3]};
            if (d0 == 0) o0 = __builtin_amdgcn_mfma_f32_32x32x16_bf16(__builtin_bit_cast(bf16x8, pw[ks]), vf, o0, 0, 0, 0);
            else o1 = __builtin_amdgcn_mfma_f32_32x32x16_bf16(__builtin_bit_cast(bf16x8, pw[ks]), vf, o1, 0, 0, 0); }
}
__device__ __forceinline__ void sb_attn_mfma(const bf16_t* Q, const bf16_t* K, const bf16_t* V, bf16_t* O, LAS unsigned char* lds, int gw, int ngw, int wave, int lane_in) {
    LAS unsigned char* vb = lds + wave * 8192;
    for (int unit = gw; unit < BATCH * SBH * (SEQ / 32); unit += ngw) {
        int lane = lane_in; asm volatile("" : "+v"(lane));
        const int r32 = lane & 31, hi = lane >> 5; const float m0 = hi == 0 ? 1.f : 0.f;
        const LAS unsigned char* vp0 = vb + ((lane >> 4) & 1) * 32 + (lane & 3) * 8 + (4 * hi + ((lane & 15) >> 2)) * 64;
        LAS unsigned char* vw = vb + lane * 16;
        const int bh = unit >> 7, qb = unit & 127, b = bh >> 4, h = bh & 15, qs = qb * 32, jd = qs >> 6;
        const bf16_t* Qw = Q + ((size_t)b * SEQ + qs + r32) * D + h * SBD + hi * 8;
        bf16x8 qr[4];
#pragma unroll
        for (int d0 = 0; d0 < 4; ++d0) qr[d0] = *(const bf16x8*)(Qw + d0 * 16);
        const bf16_t* Kh = K + (size_t)b * SEQ * D + h * SBD; const bf16_t* Vh = V + (size_t)b * SEQ * D + h * SBD;
        bf16x8 kc[8], kn[8]; u32x4 vn[8];
        int j = jd;
        sb_load_tile(kc, vn, Kh, Vh, j, lane);
#pragma unroll
        for (int w = 0; w < 8; ++w) *(LAS u32x4*)(vw + w * 1024) = vn[w];
        f32x16 o0 = {0.f, 0.f, 0.f, 0.f, 0.f, 0.f, 0.f, 0.f, 0.f, 0.f, 0.f, 0.f, 0.f, 0.f, 0.f, 0.f}, o1 = o0; float carry = 0.f;
        if (j > 0) sb_load_tile(kn, vn, Kh, Vh, j - 1, lane);
        sb_tile<true>(kc, qr, vp0, o0, o1, carry, (qs & 63) + r32 - 4 * hi, hi, m0);
        while (j > 0 && !__all(carry < -152.f)) {
#pragma unroll
            for (int w = 0; w < 8; ++w) *(LAS u32x4*)(vw + w * 1024) = vn[w];
#pragma unroll
            for (int i = 0; i < 8; ++i) kc[i] = kn[i];
            --j;
            if (j > 0) sb_load_tile(kn, vn, Kh, Vh, j - 1, lane);
            sb_tile<false>(kc, qr, vp0, o0, o1, carry, 0, hi, m0);
        }
        bf16_t* Ow = O + ((size_t)b * SEQ + qs + 4 * hi) * D + h * SBD + r32;
#pragma unroll
        for (int r = 0; r < 16; ++r) { const int q = (r & 3) + 8 * (r >> 2); const unsigned w0 = cvt_pk_bf16(o0[r], o1[r]);
            Ow[(size_t)q * D] = (bf16_t)(w0 & 0xffffu); Ow[(size_t)q * D + 32] = (bf16_t)(w0 >> 16); }
    }
}

#ifndef PROBE_SEL
#define PROBE_SEL -1
#endif
#ifndef PROBE_BLOCK
#define PROBE_BLOCK 0
#endif
struct Probe { unsigned long long last, sel, tb; };
#if PROBE_SEL >= 0
#define PH_END(k) do { const unsigned long long now_ = __builtin_amdgcn_s_memrealtime(); if ((k) == PROBE_SEL) pr.sel += now_ - pr.last; pr.last = now_; } while (0)
#define GRID_BAR() do { pr.tb = __builtin_amdgcn_s_memrealtime(); xcd_barrier(bar); if (PROBE_SEL == 13) pr.sel += __builtin_amdgcn_s_memrealtime() - pr.tb; } while (0)
#else
#define PH_END(k) do { } while (0)
#define GRID_BAR() xcd_barrier(bar)
#endif
struct Args { const float* in[10]; float* out; unsigned char* ws; };
struct Ctx { LAS unsigned char* lds; unsigned char* ws; const float* const* in; float* out; int G, bx, gw, ngw, wave, lane, tid; };

template <int L> __device__ __forceinline__ void layer(const Ctx& c, const XcdBarrier& bar, Probe& pr) {
    LAS unsigned char* lds = c.lds; unsigned char* ws = c.ws; const int G = c.G, bx = c.bx;
    const float* x = c.in[0]; float* out = c.out;
    float* ssq = (float*)(ws + WS_SSQ); float* GN = (float*)(ws + WS_GN);
    bf16_t* hbf = (bf16_t*)(ws + WS_HBF); bf16_t* wmix = (bf16_t*)(ws + WS_WMIX); bf16_t* wmlp = (bf16_t*)(ws + WS_WMLP);
    const float* base = (L == 0) ? x : out;
    if constexpr ((L & 1) == 0) {
        bf16_t* Qb = (bf16_t*)(ws + WS_Q); bf16_t* Kb = (bf16_t*)(ws + WS_K); bf16_t* Vb = (bf16_t*)(ws + WS_V);
        { pg8::StdOrder S; S.init(M, 3 * D, G, bx, hbf, wmix, D, D); EpiQKV E{Qb, ssq};
          pg8::gemm_phase<EpiQKV, pg8::StdOrder, D, D, D, true>(lds, S, E); }
        GRID_BAR(); PH_END(1);
        sb_attn_mfma(Qb, Kb, Vb, Qb, lds, c.gw, c.ngw, c.wave, c.lane);
        GRID_BAR(); PH_END(2);
        convert_mlp(L, c.in, ws, lds, c.gw, c.ngw, c.wave, c.lane);
        { pg8::StdOrder S; S.init(M, D, G, bx, Qb, wmix + (size_t)3 * D * D, D, D); EpiRes E{base, out, hbf, ssq};
          pg8::gemm_phase<EpiRes, pg8::StdOrder, D, D, D, false>(lds, S, E); }
        GRID_BAR(); PH_END(3);
    } else {
        bf16_t* SQ = (bf16_t*)(ws + WS_SQ); bf16_t* VS = (bf16_t*)(ws + WS_VS); bf16_t* KN = (bf16_t*)(ws + WS_KN); bf16_t* Y = (bf16_t*)(ws + WS_Y);
        { pg8::StdOrder S; S.init(M, 2 * D, G, bx, hbf, wmix, D, D); EpiRetQK E{SQ, KN, ssq};
          pg8::gemm_phase<EpiRetQK, pg8::StdOrder, D, D, D, true>(lds, S, E); }
        { pg8::StdOrder S; S.init(2 * D, M, G, bx, wmix + (size_t)2 * D * D, hbf, D, D); EpiRetVt E{VS, ssq};
          pg8::gemm_phase<EpiRetVt, pg8::StdOrder, D, D, D, true>(lds, S, E); }
        GRID_BAR(); PH_END(4);
        { KVOrder S{G, bx, (const char*)VS, (const char*)SQ}; EpiKV E{VS};
          pg8::gemm_phase<EpiKV, KVOrder, 512, 512, 256, true>(lds, S, E); }
        { SOrder S{G, bx, (const char*)SQ, (const char*)KN}; EpiS E{SQ};
          pg8::gemm_phase<EpiS, SOrder, 512, 1024, 256, true>(lds, S, E); }
        GRID_BAR(); PH_END(5);
        ret_scan(VS, bx * NWAVES * 64 + c.tid, G * NWAVES * 64);
        GRID_BAR(); PH_END(6);
        { OOrder S{G, bx, (const char*)SQ, (const char*)VS}; EpiO E{SQ, KN, GN};
          pg8::gemm_phase<EpiO, OOrder, 512, 512, 512, true>(lds, S, E); }
        GRID_BAR(); PH_END(7);
        { pg8::StdOrder S; S.init(M, 2 * D, G, bx, hbf, wmix + (size_t)4 * D * D, D, D); EpiG E{SQ, KN, GN, ssq, Y};
          pg8::gemm_phase<EpiG, pg8::StdOrder, D, D, D, true>(lds, S, E); }
        GRID_BAR(); PH_END(8);
        convert_mlp(L, c.in, ws, lds, c.gw, c.ngw, c.wave, c.lane);
        { pg8::StdOrder S; S.init(M, D, G, bx, Y, wmix + (size_t)6 * D * D, 2 * D, 2 * D); EpiRes E{base, out, hbf, ssq};
          pg8::gemm_phase<EpiRes, pg8::StdOrder, 2 * D, 2 * D, 2 * D, false>(lds, S, E); }
        GRID_BAR(); PH_END(9);
    }
    bf16_t* U = (bf16_t*)(ws + WS_U);
    { pg8::StdOrder S; S.init(M, FF, G, bx, hbf, wmlp, D, D); EpiUp E{U, ssq};
      pg8::gemm_phase<EpiUp, pg8::StdOrder, D, D, D, true>(lds, S, E); }
    GRID_BAR(); PH_END(10);
    if constexpr (L + 1 < NLAYER) convert_mix(L + 1, c.in, ws, lds, c.gw, c.ngw, c.wave, c.lane);
    { pg8::StdOrder S; S.init(M, D, G, bx, U, wmlp + (size_t)FF * D, FF, FF); EpiRes E{out, out, hbf, ssq};
      pg8::gemm_phase<EpiRes, pg8::StdOrder, FF, FF, FF, false>(lds, S, E); }
    GRID_BAR(); PH_END(11);
}

__global__ void __launch_bounds__(NWAVES * 64, 2) trunk_fwd(Args args) {
    extern __shared__ __attribute__((aligned(16))) unsigned char lds_raw[];
    LAS unsigned char* lds = (LAS unsigned char*)lds_raw;
    volatile LAS unsigned* MISC = (volatile LAS unsigned*)(lds + MISC_OFF);
    const int tid = threadIdx.x, lane = tid & 63, wave = __builtin_amdgcn_readfirstlane(tid >> 6);
    const int G = gridDim.x, bx = blockIdx.x;
    const int gw = bx * NWAVES + wave, ngw = G * NWAVES;
    unsigned char* ws = args.ws;
    unsigned* ctl = (unsigned*)(ws + WS_CTL);
    for (int u = tid; u < (LDS_BYTES - LDSCTL_OFF) / 4; u += NWAVES * 64) ((LAS unsigned*)(lds + LDSCTL_OFF))[u] = 0u;
    __syncthreads();
    const XcdBarrier bar = xcd_barrier_post(ctl + 4096, MISC + 8);
    const Ctx c{lds, ws, args.in, args.out, G, bx, gw, ngw, wave, lane, tid};
    Probe pr{0ull, 0ull, 0ull};
#if PROBE_SEL >= 0
    pr.last = __builtin_amdgcn_s_memrealtime();
#endif

    p0_rows(args.in[0], (bf16_t*)(ws + WS_HBF), (float*)(ws + WS_SSQ), gw, ngw, lane);
    convert_mix(0, args.in, ws, lds, gw, ngw, wave, lane);
    GRID_BAR(); PH_END(0);
    layer<0>(c, bar, pr); layer<1>(c, bar, pr); layer<2>(c, bar, pr); layer<3>(c, bar, pr);
    { int lane_f = lane; asm volatile("" : "+v"(lane_f));
      final_rows(args.out, (const float*)(ws + WS_SSQ), args.in[9], gw, ngw, lane_f); }
#if PROBE_SEL >= 0
    PH_END(12);
    if (bx == PROBE_BLOCK && tid == 0) { const unsigned long long t0 = __builtin_amdgcn_s_memrealtime(); while (__builtin_amdgcn_s_memrealtime() - t0 < 8ull * pr.sel) __builtin_amdgcn_s_sleep(8); }
#endif
}

extern "C" void kernel_launch(void* const* d_in, const int* in_sizes, int n_in, void* d_out, int out_size, void* d_ws, size_t ws_size, hipStream_t stream) {
    static int grid = 0;
    if (grid == 0) {
        if (n_in != 10 || in_sizes[0] != M * D || out_size != M * D || ws_size < WS_END) { fprintf(stderr, "kernel_launch: unexpected shapes / workspace (%d inputs, ws %zu < %zu)\n", n_in, ws_size, (size_t)WS_END); grid = -1; return; }
        int dev = 0, cus = 0, per_cu = 0;
        if (hipGetDevice(&dev) != hipSuccess || hipDeviceGetAttribute(&cus, hipDeviceAttributeMultiprocessorCount, dev) != hipSuccess) { grid = -1; return; }
        if (hipFuncSetAttribute((const void*)trunk_fwd, hipFuncAttributeMaxDynamicSharedMemorySize, LDS_BYTES) != hipSuccess) { fprintf(stderr, "kernel_launch: hipFuncSetAttribute failed\n"); grid = -1; return; }
        if (hipOccupancyMaxActiveBlocksPerMultiprocessor(&per_cu, (const void*)trunk_fwd, NWAVES * 64, LDS_BYTES) != hipSuccess || per_cu < 1) fprintf(stderr, "kernel_launch: occupancy query reports %d\n", per_cu);
        (void)hipGetLastError();
        grid = cus;
    }
    if (grid < 0) return;
    if (hipMemsetAsync((char*)d_ws + WS_CTL, 0, CTL_ZERO_BYTES, stream) != hipSuccess) return;
    Args a{};
    for (int i = 0; i < 10; ++i) a.in[i] = (const float*)d_in[i];
    a.out = (float*)d_out; a.ws = (unsigned char*)d_ws;
    hipLaunchKernelGGL(trunk_fwd, dim3(grid), dim3(NWAVES * 64), LDS_BYTES, stream, a);
}
```

```cpp
#include <hip/hip_runtime.h>
#include <cstdio>
#include <cstdint>

#define PG8_LAS __attribute__((address_space(3)))
#define GAS __attribute__((address_space(1)))
#define LAS __attribute__((address_space(3)))
typedef unsigned short bf16_t;
typedef short bf16x8 __attribute__((ext_vector_type(8)));
typedef float f32x4 __attribute__((ext_vector_type(4)));
typedef float f32x2 __attribute__((ext_vector_type(2)));
typedef unsigned u32x4 __attribute__((ext_vector_type(4)));
typedef unsigned u32x2 __attribute__((ext_vector_type(2)));

constexpr int BATCH = 4, SEQ = 4096, D = 1024, FF = 4096, NLAYER = 4;
constexpr int M = BATCH * SEQ;
constexpr int SBH = 16, SBD = 64;
constexpr int RH = 4, RDK = 256, RDV = 512, RC = 256, RNC = SEQ / RC;
constexpr int NPROB = BATCH * RH * RNC;
constexpr float RMS_EPS = 1e-6f, GN_EPS = 1e-6f;
constexpr float C2 = 0.18033688011112042f;
constexpr float L2B127 = 0.10462765653188542f;
constexpr float INV2PI = 0.15915494309189535f;
constexpr float LOG2E = 1.4426950408889634f;
__device__ __forceinline__ float lg2gamma(int h) { return h == 0 ? -0.04580368961312479f : (h == 1 ? -0.02272007650008353f : (h == 2 ? -0.011315313227834146f : -0.005646563141142063f)); }

constexpr size_t MiB = 1u << 20;
constexpr size_t WS_CTL = 0, CTL_ZERO_BYTES = 1 * MiB;
constexpr size_t WS_SSQ = 1 * MiB;
constexpr size_t WS_GN = 2 * MiB;
constexpr size_t WS_HBF = 6 * MiB;
constexpr size_t WS_WMIX = 38 * MiB;
constexpr size_t WS_SCR = 54 * MiB;
constexpr size_t WS_Q = WS_SCR, WS_K = WS_SCR + 32 * MiB, WS_V = WS_SCR + 64 * MiB;
constexpr size_t WS_SQ = WS_SCR;
constexpr size_t WS_VS = WS_SCR + 64 * MiB;
constexpr size_t WS_KN = WS_SCR + 192 * MiB;
constexpr size_t WS_Y = WS_VS;
constexpr size_t WS_U = WS_SCR;
constexpr size_t WS_WMLP = WS_SCR + 192 * MiB;
constexpr size_t WS_LOALT = WS_SCR + 128 * MiB;
constexpr size_t WS_END = WS_SCR + 224 * MiB;
constexpr size_t SQ_P = 256 * 512, VS_P = 512 * 512;

constexpr int RING_BYTES = 131072, LDSCTL_OFF = RING_BYTES, MISC_OFF = LDSCTL_OFF + 320, LDS_BYTES = 147456;
constexpr int NWAVES = 8;

__device__ __forceinline__ unsigned cvt_pk_bf16(float lo, float hi) { unsigned r; asm volatile("v_cvt_pk_bf16_f32 %0, %1, %2" : "=v"(r) : "v"(lo), "v"(hi)); return r; }
__device__ __forceinline__ float bf_lo(unsigned w) { return __uint_as_float(w << 16); }
__device__ __forceinline__ float bf_hi(unsigned w) { return __uint_as_float(w & 0xffff0000u); }
__device__ __forceinline__ u32x4 pack8(f32x4 a, f32x4 b) { u32x4 w; w.x = cvt_pk_bf16(a[0], a[1]); w.y = cvt_pk_bf16(a[2], a[3]); w.z = cvt_pk_bf16(b[0], b[1]); w.w = cvt_pk_bf16(b[2], b[3]); return w; }
__device__ __forceinline__ float wave_sum(float v) {
#pragma unroll
    for (int o = 1; o < 64; o <<= 1) v += __shfl_xor(v, o);
    return v;
}
__device__ __forceinline__ float rinv_of(float ss) { return 1.0f / sqrtf(ss * (1.0f / D) + RMS_EPS); }
#define LDS_WAIT() asm volatile("s_waitcnt lgkmcnt(0)" ::: "memory")
#define VM_WAIT() asm volatile("s_waitcnt vmcnt(0)" ::: "memory")

__device__ __forceinline__ void rinv_rows(const float* ssq, int rowbase, int fq, float (&ri)[2][4]);
namespace pg8 {
constexpr int BM = 256, BK = 64, HALF = 128, HTB = HALF * BK * 2, STAGE_BYTES = 8 * HTB, NXCD = 8, WGM = 8;
__host__ __device__ __forceinline__ int lds_byte(int r, int c) { const int st = (r >> 4) * 2 + (c >> 5), rr = r & 15, cc = c & 31, ob = rr * 64 + cc * 2; return st * 1024 + (ob ^ (((ob >> 9) & 1) << 5)); }
__host__ __device__ __forceinline__ void stage_rc(int b, int& R, int& C) { const int st = b / 1024, sb = b % 1024, swz = sb ^ (((sb >> 9) & 1) << 5); R = (st >> 1) * 16 + swz / 64; C = (st & 1) * 32 + (swz % 64) / 2; }
__host__ __device__ __forceinline__ int perm32(int rho) { const int n = rho >> 4, i = rho & 15; return 8 * (i >> 2) + 4 * n + (i & 3); }

struct Unit { int pm, pn, p; const char* a; const char* b; };

struct StdOrder {
    int nM, nN, nwg, G, c; const char* A; const char* B; size_t tA, tB;
    __device__ __forceinline__ void init(int Mr, int Nc, int G_, int c_, const void* A_, const void* B_, int lda, int ldb) { nM = Mr / BM; nN = Nc / BM; nwg = nM * nN; G = G_; c = c_; A = (const char*)A_; B = (const char*)B_; tA = (size_t)BM * lda * 2; tB = (size_t)BM * ldb * 2; }
    __device__ __forceinline__ bool next(int i, Unit& u) const {
        const long L = (long)i * G + c; if (L >= nwg) return false;
        int wgid = (int)L; { const int q = nwg / NXCD, r = nwg % NXCD, xcd = wgid % NXCD, off = wgid / NXCD; wgid = (xcd < r ? xcd * (q + 1) : r * (q + 1) + (xcd - r) * q) + off; }
        const int nig = WGM * nN, gid = wgid / nig, fm = gid * WGM, gsz = (nM - fm) < WGM ? (nM - fm) : WGM;
        u.pm = fm + ((wgid % nig) % gsz); u.pn = (wgid % nig) / gsz; u.p = 0; u.a = A + (size_t)u.pm * tA; u.b = B + (size_t)u.pn * tB; return true;
    }
};

template <class Epi, class Sched, int LDA, int LDB, int KD, bool ALIGN_EPI>
__device__ __forceinline__ void gemm_phase(PG8_LAS unsigned char* lds, const Sched& S, const Epi& E) {
    int tid = threadIdx.x; asm volatile("" : "+v"(tid));
    const int wid = __builtin_amdgcn_readfirstlane(tid >> 6), lane = tid & 63, wr = wid >> 2, wc = wid & 3, fr = lane & 15, fq = lane >> 4;
    constexpr int nt = KD / BK;
    static_assert(KD % 128 == 0 && KD >= 256, "K multiple of 128, >= 256");
    unsigned voffA[2], voffB[2];
#pragma unroll
    for (int i = 0; i < 2; ++i) { int R, C; stage_rc(tid * 16 + i * 8192, R, C); const int Rb = (R & ~31) + perm32(R & 31);
        voffA[i] = (unsigned)(R * LDA + C) * 2u; voffB[i] = (unsigned)(Rb * LDB + C) * 2u; }
    constexpr size_t kstep = (size_t)(BK * 2), hstepA = (size_t)HALF * LDA * 2, hstepB = (size_t)HALF * LDB * 2;
    const unsigned ldsw = (unsigned)wid * 1024u;
    const int aoff = lds_byte(wr * 64 + fr, fq * 8), boff = lds_byte(wc * 32 + fr, fq * 8);
#define PG8_SA(b, h) (((b) * 2 + (h)) * HTB)
#define PG8_SB(b, h) ((4 + (b) * 2 + (h)) * HTB)
#define PG8_STAGE(bufoff, gbase, voff) do { _Pragma("unroll") for (int _i = 0; _i < 2; ++_i) \
        __builtin_amdgcn_global_load_lds((const unsigned*)((const char*)(gbase) + (voff)[_i]), (PG8_LAS unsigned*)(lds + (bufoff) + ldsw + _i * 8192), 16, 0, 0); } while (0)
#define PG8_LDA(dst, b, h) do { _Pragma("unroll") for (int m = 0; m < 4; ++m) _Pragma("unroll") for (int k = 0; k < 2; ++k) dst[m][k] = *(const PG8_LAS bf16x8*)(lds + PG8_SA(b, h) + aoff + m * 2048 + k * 1024); } while (0)
#define PG8_LDB(dst, b, h) do { _Pragma("unroll") for (int n = 0; n < 2; ++n) _Pragma("unroll") for (int k = 0; k < 2; ++k) dst[n][k] = *(const PG8_LAS bf16x8*)(lds + PG8_SB(b, h) + boff + n * 2048 + k * 1024); } while (0)
#define PG8_MMA(ai, bj, At, Bt) do { __builtin_amdgcn_s_setprio(1); _Pragma("unroll") for (int m = 0; m < 4; ++m) _Pragma("unroll") for (int n = 0; n < 2; ++n) _Pragma("unroll") for (int k = 0; k < 2; ++k) \
        acc[ai][bj][m][n] = __builtin_amdgcn_mfma_f32_16x16x32_bf16(Bt[n][k], At[m][k], acc[ai][bj][m][n], 0, 0, 0); __builtin_amdgcn_s_setprio(0); } while (0)
#define PG8_WAIT_V(n) asm volatile("s_waitcnt vmcnt(" #n ")" ::: "memory")
#define PG8_WAIT_L(n) asm volatile("s_waitcnt lgkmcnt(" #n ")" ::: "memory")
#define PG8_BAR __builtin_amdgcn_s_barrier()
#define PG8_SCHED __builtin_amdgcn_sched_barrier(0)
    Unit cur, nxt; int ui = 0;
    if (!S.next(0, cur)) return;
    float ri[2][4];
    if constexpr (Epi::USES_RI) { int fr_ = fr, fq_ = fq; asm volatile("" : "+v"(fr_), "+v"(fq_)); ::rinv_rows(E.ssq, cur.pm * 256 + wr * 64 + fr_, fq_, ri); }
    f32x4 acc[2][2][4][2];
#pragma unroll
    for (int a = 0; a < 2; ++a)
#pragma unroll
        for (int b = 0; b < 2; ++b)
#pragma unroll
            for (int m = 0; m < 4; ++m)
#pragma unroll
                for (int n = 0; n < 2; ++n) acc[a][b][m][n] = (f32x4){0.f, 0.f, 0.f, 0.f};
    bf16x8 At[4][2], B0[2][2], B1[2][2];
    const char* cA = cur.a; const char* cB = cur.b;
    PG8_STAGE(PG8_SB(0, 0), cB, voffB); PG8_STAGE(PG8_SB(0, 1), cB + hstepB, voffB); PG8_STAGE(PG8_SA(0, 0), cA, voffA); PG8_STAGE(PG8_SA(0, 1), cA + hstepA, voffA);
    if (wr == 1) PG8_BAR;
    PG8_WAIT_V(2); PG8_BAR;
    PG8_STAGE(PG8_SB(1, 0), cB + kstep, voffB); PG8_STAGE(PG8_SA(1, 0), cA + kstep, voffA); PG8_STAGE(PG8_SB(1, 1), cB + hstepB + kstep, voffB);
    PG8_WAIT_V(6); PG8_BAR;
    for (;;) {
        const bool has_next = S.next(ui + 1, nxt);
        const char* nA = has_next ? nxt.a : cA; const char* nB = has_next ? nxt.b : cB;
#pragma nounroll
        for (int t = 0; t < nt; t += 2) {
            const bool last = (t == nt - 2);
            const char* a1 = cA + (size_t)(t + 1) * kstep;
            const char* a2 = last ? nA : cA + (size_t)(t + 2) * kstep; const char* b2 = last ? nB : cB + (size_t)(t + 2) * kstep;
            const char* a3 = a2 + kstep; const char* b3 = b2 + kstep;
            PG8_LDB(B0, 0, 0); PG8_LDB(B1, 0, 1); PG8_SCHED; PG8_LDA(At, 0, 0); PG8_STAGE(PG8_SA(1, 1), a1 + hstepA, voffA);
            PG8_WAIT_V(8); PG8_WAIT_L(0); PG8_BAR; PG8_MMA(0, 0, At, B0); PG8_MMA(0, 1, At, B1); PG8_BAR; PG8_SCHED;
            PG8_LDA(At, 0, 1); PG8_STAGE(PG8_SB(0, 0), b2, voffB); PG8_STAGE(PG8_SB(0, 1), b2 + hstepB, voffB); PG8_STAGE(PG8_SA(0, 0), a2, voffA);
            PG8_WAIT_V(8); PG8_WAIT_L(0); PG8_BAR; PG8_MMA(1, 0, At, B0); PG8_MMA(1, 1, At, B1); PG8_BAR; PG8_SCHED;
            PG8_LDB(B0, 1, 0); PG8_LDB(B1, 1, 1); PG8_SCHED; PG8_LDA(At, 1, 0); PG8_STAGE(PG8_SA(0, 1), a2 + hstepA, voffA);
            PG8_WAIT_V(8); PG8_WAIT_L(0); PG8_BAR; PG8_MMA(0, 0, At, B0); PG8_MMA(0, 1, At, B1); PG8_BAR; PG8_SCHED;
            PG8_LDA(At, 1, 1); PG8_STAGE(PG8_SB(1, 0), b3, voffB); PG8_STAGE(PG8_SB(1, 1), b3 + hstepB, voffB); PG8_STAGE(PG8_SA(1, 0), a3, voffA);
            PG8_WAIT_V(8); PG8_WAIT_L(0); PG8_BAR; PG8_MMA(1, 0, At, B0); PG8_MMA(1, 1, At, B1); PG8_BAR; PG8_SCHED;
        }
        if constexpr (ALIGN_EPI) { if (wr == 0) PG8_BAR; }
        E(acc, cur, has_next, nxt, ri, wr, wc, fr, fq);
        if (!has_next) break;
#pragma unroll
        for (int a = 0; a < 2; ++a)
#pragma unroll
            for (int b = 0; b < 2; ++b)
#pragma unroll
                for (int m = 0; m < 4; ++m)
#pragma unroll
                    for (int n = 0; n < 2; ++n) acc[a][b][m][n] = (f32x4){0.f, 0.f, 0.f, 0.f};
        cur = nxt; cA = nA; cB = nB; ++ui;
        if constexpr (ALIGN_EPI) { if (wr == 1) PG8_BAR; }
    }
    PG8_WAIT_V(0);
    if constexpr (!ALIGN_EPI) { if (wr == 0) PG8_BAR; }
    PG8_BAR;
#undef PG8_SA
#undef PG8_SB
#undef PG8_STAGE
#undef PG8_LDA
#undef PG8_LDB
#undef PG8_MMA
#undef PG8_WAIT_V
#undef PG8_WAIT_L
#undef PG8_BAR
#undef PG8_SCHED
}
typedef f32x4 Acc[2][2][4][2];
}
using pg8::Unit;

__device__ __forceinline__ void ri_issue(const float* ssq, int rowbase, int fq, f32x4 (&raw)[2][4]) {
#pragma unroll
    for (int ai = 0; ai < 2; ++ai)
#pragma unroll
        for (int m = 0; m < 4; ++m) raw[ai][m] = *(const f32x4*)(ssq + (size_t)(rowbase + ai * 128 + m * 16) * 16 + fq * 4);
}
__device__ __forceinline__ void ri_reduce(const f32x4 (&raw)[2][4], float (&ri)[2][4]) {
#pragma unroll
    for (int ai = 0; ai < 2; ++ai)
#pragma unroll
        for (int m = 0; m < 4; ++m) { const f32x4 v = raw[ai][m]; float s = (v[0] + v[1]) + (v[2] + v[3]); s += __shfl_xor(s, 16); s += __shfl_xor(s, 32); ri[ai][m] = rinv_of(s); }
}
__device__ __forceinline__ void rinv_rows(const float* ssq, int rowbase, int fq, float (&ri)[2][4]) { f32x4 raw[2][4]; ri_issue(ssq, rowbase, fq, raw); ri_reduce(raw, ri); }
__device__ __forceinline__ void rinv_cols(const float* ssq, int colbase  , int fr, int lane, float (&rc)[2][8]) {
    const int tok = colbase + 128 * (fr >> 3) + (fr & 7); const f32x4* p = (const f32x4*)(ssq + (size_t)tok * 16);
    const f32x4 a = p[0], b = p[1], c = p[2], d = p[3];
    const float s = (((a[0] + a[1]) + (a[2] + a[3])) + ((b[0] + b[1]) + (b[2] + b[3]))) + (((c[0] + c[1]) + (c[2] + c[3])) + ((d[0] + d[1]) + (d[2] + d[3])));
    const float r = rinv_of(s);
#pragma unroll
    for (int bj = 0; bj < 2; ++bj)
#pragma unroll
        for (int q = 0; q < 8; ++q) rc[bj][q] = __shfl(r, (lane & 48) | (bj * 8 + q));
}
__device__ __forceinline__ void sincos_rev(float ang, float& sn, float& cs) { float rev = ang * INV2PI; rev = __builtin_amdgcn_fractf(rev); sn = __builtin_amdgcn_sinf(rev); cs = __builtin_amdgcn_cosf(rev); }

struct EpiQKV { static constexpr bool PERM = true, USES_RI = true; bf16_t* q; const float* ssq;
    __device__ __forceinline__ void operator()(const pg8::Acc& acc, const Unit& u, bool has_next, const Unit& nxt, float (&ri)[2][4], int wr, int wc, int fr, int fq) const {
        asm volatile("" : "+v"(fr), "+v"(fq));
        const int t = u.pn >> 2; bf16_t* base = q + (size_t)t * ((WS_K - WS_Q) / 2); const float sc = t == 0 ? C2 : 1.f;
        const int row0 = u.pm * 256 + wr * 64 + fr, col0 = (u.pn & 3) * 256 + wc * 32 + 8 * fq;
        f32x4 nraw[2][4]; if (has_next) ri_issue(ssq, nxt.pm * 256 + wr * 64 + fr, fq, nraw);
#pragma unroll
        for (int ai = 0; ai < 2; ++ai)
#pragma unroll
            for (int m = 0; m < 4; ++m) { const float s = ri[ai][m] * sc; bf16_t* rowp = base + (size_t)(row0 + ai * 128 + m * 16) * D + col0;
#pragma unroll
                for (int bj = 0; bj < 2; ++bj) *(u32x4*)(rowp + bj * 128) = pack8(acc[ai][bj][m][0] * s, acc[ai][bj][m][1] * s); }
        if (has_next) ri_reduce(nraw, ri);
    }
};
template <bool FINAL> struct EpiResT { static constexpr bool PERM = true, USES_RI = false; bf16_t* hbf; const bf16_t* lo_in; bf16_t* lo_out; float* out; float* ssq;
    __device__ __forceinline__ void operator()(const pg8::Acc& acc, const Unit& u, bool has_next, const Unit& nxt, float (&ri)[2][4], int wr, int wc, int fr, int fq) const {
        asm volatile("" : "+v"(fr), "+v"(fq));
        const int row0 = u.pm * 256 + wr * 64 + fr, col0 = u.pn * 256 + wc * 32 + 8 * fq;
        u32x4 nb[4];
        { const size_t off = (size_t)row0 * D + col0;
#pragma unroll
          for (int bj = 0; bj < 2; ++bj) { nb[2 * bj] = *(const u32x4*)(hbf + off + bj * 128); nb[2 * bj + 1] = *(const u32x4*)(lo_in + off + bj * 128); } }
#pragma unroll
        for (int g = 0; g < 8; ++g) { const int ai = g >> 2, m = g & 3; const int row = row0 + ai * 128 + m * 16; const size_t off = (size_t)row * D + col0; float ss = 0.f;
            u32x4 cb[4];
#pragma unroll
            for (int k = 0; k < 4; ++k) cb[k] = nb[k];
            if (g < 7) { const size_t noff = (size_t)(row0 + ((g + 1) >> 2) * 128 + ((g + 1) & 3) * 16) * D + col0;
#pragma unroll
                for (int bj = 0; bj < 2; ++bj) { nb[2 * bj] = *(const u32x4*)(hbf + noff + bj * 128); nb[2 * bj + 1] = *(const u32x4*)(lo_in + noff + bj * 128); } }
            asm volatile("" ::: "memory");
#pragma unroll
            for (int bj = 0; bj < 2; ++bj) { const u32x4 hw = cb[2 * bj], lw = cb[2 * bj + 1];
                f32x4 h0, h1;
                h0[0] = (bf_lo(hw.x) + bf_lo(lw.x)) + acc[ai][bj][m][0][0]; h0[1] = (bf_hi(hw.x) + bf_hi(lw.x)) + acc[ai][bj][m][0][1]; h0[2] = (bf_lo(hw.y) + bf_lo(lw.y)) + acc[ai][bj][m][0][2]; h0[3] = (bf_hi(hw.y) + bf_hi(lw.y)) + acc[ai][bj][m][0][3];
                h1[0] = (bf_lo(hw.z) + bf_lo(lw.z)) + acc[ai][bj][m][1][0]; h1[1] = (bf_hi(hw.z) + bf_hi(lw.z)) + acc[ai][bj][m][1][1]; h1[2] = (bf_lo(hw.w) + bf_lo(lw.w)) + acc[ai][bj][m][1][2]; h1[3] = (bf_hi(hw.w) + bf_hi(lw.w)) + acc[ai][bj][m][1][3];
                if (FINAL) { *(f32x4*)(out + off + bj * 128) = h0; *(f32x4*)(out + off + bj * 128 + 4) = h1; }
                else { const u32x4 nh = pack8(h0, h1);
                    f32x4 d0, d1; d0[0] = h0[0] - bf_lo(nh.x); d0[1] = h0[1] - bf_hi(nh.x); d0[2] = h0[2] - bf_lo(nh.y); d0[3] = h0[3] - bf_hi(nh.y); d1[0] = h1[0] - bf_lo(nh.z); d1[1] = h1[1] - bf_hi(nh.z); d1[2] = h1[2] - bf_lo(nh.w); d1[3] = h1[3] - bf_hi(nh.w);
                    *(u32x4*)(hbf + off + bj * 128) = nh; *(u32x4*)(lo_out + off + bj * 128) = pack8(d0, d1); }
                ss += ((h0[0] * h0[0] + h0[1] * h0[1]) + (h0[2] * h0[2] + h0[3] * h0[3])) + ((h1[0] * h1[0] + h1[1] * h1[1]) + (h1[2] * h1[2] + h1[3] * h1[3])); }
            ss += __shfl_xor(ss, 16); ss += __shfl_xor(ss, 32); if (fq == 0) ssq[(size_t)row * 16 + u.pn * 4 + wc] = ss; }
    }
};
struct EpiUp { static constexpr bool PERM = true, USES_RI = true; bf16_t* uo; const float* ssq;
    __device__ __forceinline__ void operator()(const pg8::Acc& acc, const Unit& u, bool has_next, const Unit& nxt, float (&ri)[2][4], int wr, int wc, int fr, int fq) const {
        asm volatile("" : "+v"(fr), "+v"(fq));
        const int row0 = u.pm * 256 + wr * 64 + fr, col0 = u.pn * 256 + wc * 32 + 8 * fq;
        f32x4 nraw[2][4]; if (has_next) ri_issue(ssq, nxt.pm * 256 + wr * 64 + fr, fq, nraw);
#pragma unroll
        for (int ai = 0; ai < 2; ++ai)
#pragma unroll
            for (int m = 0; m < 4; ++m) { const float s = ri[ai][m]; bf16_t* rowp = uo + (size_t)(row0 + ai * 128 + m * 16) * FF + col0;
#pragma unroll
                for (int bj = 0; bj < 2; ++bj) { f32x4 a = acc[ai][bj][m][0] * s, b = acc[ai][bj][m][1] * s;
#pragma unroll
                    for (int e = 0; e < 4; ++e) { const float x = fmaxf(a[e], 0.f), y = fmaxf(b[e], 0.f); a[e] = x * x; b[e] = y * y; }
                    *(u32x4*)(rowp + bj * 128) = pack8(a, b); } }
        if (has_next) ri_reduce(nraw, ri);
    }
};
struct EpiRetQK { static constexpr bool PERM = true, USES_RI = true; bf16_t* SQ; bf16_t* KN; const float* ssq;
    __device__ __forceinline__ void operator()(const pg8::Acc& acc, const Unit& u, bool has_next, const Unit& nxt, float (&ri)[2][4], int wr, int wc, int fr, int fq) const {
        asm volatile("" : "+v"(fr), "+v"(fq));
        const bool isq = u.pn < 4; const int h = u.pn & 3, b = u.pm >> 4, N = u.pm & 15, p = (b * 4 + h) * 16 + N;
        const int row0 = u.pm * 256 + wr * 64 + fr, i0 = wr * 64 + fr, cb = wc * 32 + 8 * fq; const float lg = lg2gamma(h);
        f32x4 nraw[2][4]; if (has_next) ri_issue(ssq, nxt.pm * 256 + wr * 64 + fr, fq, nraw);
        float invf[8];
#pragma unroll
        for (int q = 0; q < 8; ++q) invf[q] = __builtin_amdgcn_exp2f(-(float)(cb + q) * L2B127);
#pragma unroll
        for (int ai = 0; ai < 2; ++ai)
#pragma unroll
            for (int m = 0; m < 4; ++m) { const int il = i0 + ai * 128 + m * 16; const float pos = (float)(N * 256 + il);
                const float s = ri[ai][m], sc = isq ? __builtin_amdgcn_exp2f(lg * (float)(il + 1)) : 0.0625f;
                f32x4 y1[2], y2[2];
#pragma unroll
                for (int n = 0; n < 2; ++n)
#pragma unroll
                    for (int e = 0; e < 4; ++e) { float sn, cs; sincos_rev(pos * invf[n * 4 + e], sn, cs); const float x1 = acc[ai][0][m][n][e] * s, x2 = acc[ai][1][m][n][e] * s;
                        y1[n][e] = (x1 * cs - x2 * sn) * sc; y2[n][e] = (x1 * sn + x2 * cs) * sc; }
                bf16_t* dst = isq ? SQ + (size_t)p * SQ_P + (size_t)il * 512 + 256 + cb : KN + (size_t)(row0 + ai * 128 + m * 16) * 1024 + h * 256 + cb;
                *(u32x4*)dst = pack8(y1[0], y1[1]); *(u32x4*)(dst + 128) = pack8(y2[0], y2[1]);
                if (!isq) {
                    const float kd = __builtin_amdgcn_exp2f(lg * (float)(255 - il)); bf16_t* tb = SQ + (size_t)p * SQ_P + (size_t)cb * 512 + il;
#pragma unroll
                    for (int n = 0; n < 2; ++n)
#pragma unroll
                        for (int e = 0; e < 4; e += 2) { const unsigned w1 = cvt_pk_bf16(y1[n][e] * kd, y1[n][e + 1] * kd), w2 = cvt_pk_bf16(y2[n][e] * kd, y2[n][e + 1] * kd); const int dq = n * 4 + e;
                            tb[(size_t)dq * 512] = (bf16_t)(w1 & 0xffffu); tb[(size_t)(dq + 1) * 512] = (bf16_t)(w1 >> 16);
                            tb[(size_t)(128 + dq) * 512] = (bf16_t)(w2 & 0xffffu); tb[(size_t)(129 + dq) * 512] = (bf16_t)(w2 >> 16); } }
                __builtin_amdgcn_sched_barrier(0); }
        if (has_next) ri_reduce(nraw, ri);
    }
};
struct EpiRetVt { static constexpr bool PERM = true, USES_RI = false; bf16_t* VS; const float* ssq;
    __device__ __forceinline__ void operator()(const pg8::Acc& acc, const Unit& u, bool has_next, const Unit& nxt, float (&ri)[2][4], int wr, int wc, int fr, int fq) const {
        asm volatile("" : "+v"(fr), "+v"(fq));
        const int lane = fq * 16 + fr; const int b = u.pn >> 4, N = u.pn & 15, jb = wc * 32 + 8 * fq;
        float rc[2][8]; rinv_cols(ssq, u.pn * 256 + jb, fr, lane, rc);
        const int h = u.pm >> 1, eh = u.pm & 1, p = (b * 4 + h) * 16 + N;
#pragma unroll
        for (int ai = 0; ai < 2; ++ai)
#pragma unroll
            for (int m = 0; m < 4; ++m) { const int e_row = eh * 256 + ai * 128 + wr * 64 + m * 16 + fr;
#pragma unroll
                for (int bj = 0; bj < 2; ++bj) { f32x4 a = acc[ai][bj][m][0], c = acc[ai][bj][m][1];
#pragma unroll
                    for (int e = 0; e < 4; ++e) { a[e] *= rc[bj][e]; c[e] *= rc[bj][4 + e]; }
                    *(u32x4*)(VS + (size_t)p * VS_P + (size_t)e_row * 512 + bj * 128 + jb) = pack8(a, c); } }
    }
};
struct EpiKV { static constexpr bool PERM = true, USES_RI = false; bf16_t* VS;
    __device__ __forceinline__ void operator()(const pg8::Acc& acc, const Unit& u, bool has_next, const Unit& nxt, float (&ri)[2][4], int wr, int wc, int fr, int fq) const {
        asm volatile("" : "+v"(fr), "+v"(fq));
        bf16_t* base = VS + (size_t)u.p * VS_P + 256 + wc * 32 + 8 * fq;
#pragma unroll
        for (int ai = 0; ai < 2; ++ai)
#pragma unroll
            for (int m = 0; m < 4; ++m) { const int e_row = u.pm * 256 + ai * 128 + wr * 64 + m * 16 + fr;
#pragma unroll
                for (int bj = 0; bj < 2; ++bj) *(u32x4*)(base + (size_t)e_row * 512 + bj * 128) = pack8(acc[ai][bj][m][0], acc[ai][bj][m][1]); }
    }
};
struct EpiS { static constexpr bool PERM = true, USES_RI = false; bf16_t* SQ;
    __device__ __forceinline__ void operator()(const pg8::Acc& acc, const Unit& u, bool has_next, const Unit& nxt, float (&ri)[2][4], int wr, int wc, int fr, int fq) const {
        asm volatile("" : "+v"(fr), "+v"(fq));
        const int h = (u.p >> 4) & 3, jb = wc * 32 + 8 * fq; const float lg = lg2gamma(h);
        float gi[2][8];
#pragma unroll
        for (int bj = 0; bj < 2; ++bj)
#pragma unroll
            for (int q = 0; q < 8; ++q) gi[bj][q] = __builtin_amdgcn_exp2f(-lg * (float)(bj * 128 + jb + q + 1));
#pragma unroll
        for (int ai = 0; ai < 2; ++ai)
#pragma unroll
            for (int m = 0; m < 4; ++m) { const int i = ai * 128 + wr * 64 + m * 16 + fr;
#pragma unroll
                for (int bj = 0; bj < 2; ++bj) { f32x4 a = acc[ai][bj][m][0], c = acc[ai][bj][m][1];
#pragma unroll
                    for (int e = 0; e < 4; ++e) { const int d0 = i - (bj * 128 + jb + e);
                        a[e] = __uint_as_float(__float_as_uint(a[e] * gi[bj][e]) & ~(unsigned)(d0 >> 31)); c[e] = __uint_as_float(__float_as_uint(c[e] * gi[bj][4 + e]) & ~(unsigned)((d0 - 4) >> 31)); }
                    *(u32x4*)(SQ + (size_t)u.p * SQ_P + (size_t)i * 512 + bj * 128 + jb) = pack8(a, c); } __builtin_amdgcn_sched_barrier(0); }
    }
};
struct EpiO { static constexpr bool PERM = true, USES_RI = false; bf16_t* SQ; bf16_t* OH0; float* GN;
    __device__ __forceinline__ void operator()(const pg8::Acc& acc, const Unit& u, bool has_next, const Unit& nxt, float (&ri)[2][4], int wr, int wc, int fr, int fq) const {
        asm volatile("" : "+v"(fr), "+v"(fq));
        const int bh = u.p >> 4, N = u.p & 15, b = bh >> 2, h = bh & 3, cb = wc * 32 + 8 * fq;
        bf16_t* ob = u.pn == 0 ? OH0 + (size_t)u.p * 65536 : SQ + (size_t)u.p * SQ_P; const int pitch = u.pn == 0 ? 256 : 512;
#pragma unroll
        for (int ai = 0; ai < 2; ++ai)
#pragma unroll
            for (int m = 0; m < 4; ++m) { const int i = ai * 128 + wr * 64 + m * 16 + fr; float s = 0.f, q = 0.f;
#pragma unroll
                for (int bj = 0; bj < 2; ++bj) { const f32x4 a = acc[ai][bj][m][0], c = acc[ai][bj][m][1];
                    s += ((a[0] + a[1]) + (a[2] + a[3])) + ((c[0] + c[1]) + (c[2] + c[3]));
                    q += ((a[0] * a[0] + a[1] * a[1]) + (a[2] * a[2] + a[3] * a[3])) + ((c[0] * c[0] + c[1] * c[1]) + (c[2] * c[2] + c[3] * c[3]));
                    *(u32x4*)(ob + (size_t)i * pitch + bj * 128 + cb) = pack8(a, c); }
                s += __shfl_xor(s, 16); s += __shfl_xor(s, 32); q += __shfl_xor(q, 16); q += __shfl_xor(q, 32);
                if (fq == 0) { const size_t tok = (size_t)b * SEQ + N * 256 + i; *(f32x2*)(GN + (tok * 4 + h) * 16 + (u.pn * 4 + wc) * 2) = (f32x2){s, q}; } }
    }
};
struct EpiG { static constexpr bool PERM = true, USES_RI = true; const bf16_t* SQ; const bf16_t* OH0; const float* GN; const float* ssq; bf16_t* Y;
    __device__ __forceinline__ void operator()(const pg8::Acc& acc, const Unit& u, bool has_next, const Unit& nxt, float (&ri)[2][4], int wr, int wc, int fr, int fq) const {
        asm volatile("" : "+v"(fr), "+v"(fq));
        const int b = u.pm >> 4, N = u.pm & 15, h = u.pn >> 1, eh = u.pn & 1, p = (b * 4 + h) * 16 + N, cb = wc * 32 + 8 * fq;
        const int row0 = u.pm * 256 + wr * 64 + fr, i0 = wr * 64 + fr;
        f32x4 nraw[2][4]; if (has_next) ri_issue(ssq, nxt.pm * 256 + wr * 64 + fr, fq, nraw);
        const bf16_t* ob = (eh == 0 ? OH0 + (size_t)p * 65536 : SQ + (size_t)p * SQ_P) + cb; const int pitch = eh == 0 ? 256 : 512;
        const float* gnb = GN + ((size_t)row0 * 4 + h) * 16 + fq * 4;
        u32x4 no[2]; f32x4 nst;
        no[0] = *(const u32x4*)(ob + (size_t)i0 * pitch); no[1] = *(const u32x4*)(ob + (size_t)i0 * pitch + 128); nst = *(const f32x4*)gnb;
#pragma unroll
        for (int g = 0; g < 8; ++g) { const int ai = g >> 2, m = g & 3; const size_t tok = (size_t)row0 + ai * 128 + m * 16;
            const u32x4 co[2] = {no[0], no[1]}; const f32x4 st = nst;
            if (g < 7) { const int r1 = ((g + 1) >> 2) * 128 + ((g + 1) & 3) * 16;
                no[0] = *(const u32x4*)(ob + (size_t)(i0 + r1) * pitch); no[1] = *(const u32x4*)(ob + (size_t)(i0 + r1) * pitch + 128); nst = *(const f32x4*)(gnb + (size_t)r1 * 64); }
            asm volatile("" ::: "memory");
            float s = st[0] + st[2], q = st[1] + st[3];
            s += __shfl_xor(s, 16); s += __shfl_xor(s, 32); q += __shfl_xor(q, 16); q += __shfl_xor(q, 32);
            const float mu = s * (1.0f / RDV), var = fmaxf(q * (1.0f / RDV) - mu * mu, 0.f), rstd = 1.0f / sqrtf(var + GN_EPS), rr = ri[ai][m];
#pragma unroll
            for (int bj = 0; bj < 2; ++bj) { const u32x4 ow = co[bj]; f32x4 a = acc[ai][bj][m][0] * rr, c = acc[ai][bj][m][1] * rr;
                const float o8[8] = {bf_lo(ow.x), bf_hi(ow.x), bf_lo(ow.y), bf_hi(ow.y), bf_lo(ow.z), bf_hi(ow.z), bf_lo(ow.w), bf_hi(ow.w)};
#pragma unroll
                for (int e = 0; e < 4; ++e) { const float g0 = a[e], g1 = c[e];
                    a[e] = g0 * __builtin_amdgcn_rcpf(1.f + __builtin_amdgcn_exp2f(-g0 * LOG2E)) * ((o8[e] - mu) * rstd);
                    c[e] = g1 * __builtin_amdgcn_rcpf(1.f + __builtin_amdgcn_exp2f(-g1 * LOG2E)) * ((o8[4 + e] - mu) * rstd); }
                *(u32x4*)(Y + tok * 2048 + h * 512 + eh * 256 + bj * 128 + cb) = pack8(a, c); } }
        if (has_next) ri_reduce(nraw, ri);
    }
};

struct KVOrder { int G, c; const char* VS; const char* SQ;
    __device__ __forceinline__ bool next(int i, Unit& u) const { const int p = c + (i >> 1) * G; if (p >= NPROB) return false; u.p = p; u.pm = i & 1; u.pn = 0;
        u.a = VS + (size_t)p * VS_P * 2 + (size_t)u.pm * 256 * 512 * 2; u.b = SQ + (size_t)p * SQ_P * 2; return true; } };
struct SOrder { int G, c; const char* SQ; const char* KN;
    __device__ __forceinline__ bool next(int i, Unit& u) const { const int p = c + i * G; if (p >= NPROB) return false; u.p = p; u.pm = 0; u.pn = 0;
        const int bh = p >> 4, N = p & 15, b = bh >> 2, h = bh & 3; u.a = SQ + (size_t)p * SQ_P * 2 + 512; u.b = KN + ((size_t)(b * SEQ + N * 256) * 1024 + h * 256) * 2; return true; } };
struct OOrder { int G, c; const char* SQ; const char* VS;
    __device__ __forceinline__ bool next(int i, Unit& u) const { const int p = c + (i >> 1) * G; if (p >= NPROB) return false; u.p = p; u.pm = 0; u.pn = i & 1;
        u.a = SQ + (size_t)p * SQ_P * 2; u.b = VS + (size_t)p * VS_P * 2 + (size_t)u.pn * 256 * 512 * 2; return true; } };

#define XB_TMO      128
#define XB_XCNT(j)  (256  + 64 * (j))
#define XB_XSUB(j)  (1280 + 64 * (j))
#define XB_XGEN(j)  (2304 + 64 * (j))
#define XB_TOP      3328
#define XB_TOPGEN   3392
#define XCD_BAR_WORDS 3456
#define XB_SPIN_CAP (1u << 18)
__device__ __forceinline__ unsigned xb_ld(unsigned* p)              { return __hip_atomic_load(p, __ATOMIC_RELAXED, __HIP_MEMORY_SCOPE_AGENT); }
__device__ __forceinline__ unsigned xb_add(unsigned* p, unsigned v) { return __hip_atomic_fetch_add(p, v, __ATOMIC_RELAXED, __HIP_MEMORY_SCOPE_AGENT); }
__device__ __forceinline__ unsigned xb_xcc_id() { return (unsigned)__builtin_amdgcn_s_getreg((3 << 11) | 20) & 0xFu; }
#define XB_SPIN(cond, bar) do { unsigned _sp = 0; while (cond) { __builtin_amdgcn_s_sleep(1); \
    if ((++_sp & 255u) == 0u) { if (xb_ld(&(bar)[XB_TMO])) break; if (_sp > XB_SPIN_CAP) { atomicAdd(&(bar)[XB_TMO], 1u); break; } } } } while (0)
struct XcdBarrier { unsigned* bar; unsigned x; volatile LAS unsigned* st; };
__device__ __forceinline__ XcdBarrier xcd_barrier_post(unsigned* bar, volatile LAS unsigned* st) {
    XcdBarrier b; b.bar = bar; b.x = xb_xcc_id(); b.st = st;
    if (threadIdx.x == 0) (void)xb_add(&bar[XB_XCNT(b.x)], 1u);
    return b;
}
__device__ __forceinline__ void xcd_barrier_complete(unsigned* bar, unsigned x, unsigned& nloc, unsigned& nx) {
    const unsigned G = gridDim.x * gridDim.y * gridDim.z;
    unsigned sum, cnt, mine, sp = 0u;
    for (;;) {
        sum = 0u; cnt = 0u; mine = 0u;
#pragma unroll
        for (unsigned j = 0; j < 16; ++j) { const unsigned c = xb_ld(&bar[XB_XCNT(j)]); sum += c; cnt += (c > 0u) ? 1u : 0u; mine = (j == x) ? c : mine; }
        if (sum == G) break;
        __builtin_amdgcn_s_sleep(1);
        if ((++sp & 255u) == 0u) { if (xb_ld(&bar[XB_TMO])) break; if (sp > XB_SPIN_CAP) { atomicAdd(&bar[XB_TMO], 1u); break; } }
    }
    nloc = mine > 0u ? mine : 1u; nx = cnt > 0u ? cnt : 1u;
}
__device__ __forceinline__ void xcd_barrier(const XcdBarrier& b) {
    asm volatile("s_waitcnt vmcnt(0)" ::: "memory");
    __syncthreads();
    if (threadIdx.x == 0) {
        unsigned* bar = b.bar;
        __builtin_amdgcn_s_waitcnt(0);
        unsigned nloc = b.st[0], nx = b.st[1];
        if (nloc == 0u) { xcd_barrier_complete(bar, b.x, nloc, nx); b.st[0] = nloc; b.st[1] = nx; }
        const unsigned old = xb_add(&bar[XB_XSUB(b.x)], 1u);
        const unsigned gen = old / nloc;
        if (old + 1u == (gen + 1u) * nloc) {
            __builtin_amdgcn_fence(__ATOMIC_RELEASE, "agent");
            asm volatile("s_waitcnt vmcnt(0)" ::: "memory");
            const unsigned og = xb_add(&bar[XB_TOP], 1u);
            const unsigned tg = og / nx;
            if (og + 1u == (tg + 1u) * nx) xb_add(&bar[XB_TOPGEN], 1u);
            else XB_SPIN(xb_ld(&bar[XB_TOPGEN]) == tg, bar);
            __builtin_amdgcn_fence(__ATOMIC_ACQUIRE, "agent");
            xb_add(&bar[XB_XGEN(b.x)], 1u);
            asm volatile("s_waitcnt vmcnt(0)" ::: "memory");
        } else {
            XB_SPIN(xb_ld(&bar[XB_XGEN(b.x)]) == gen, bar);
            __builtin_amdgcn_fence(__ATOMIC_ACQUIRE, "agent");
            asm volatile("s_waitcnt vmcnt(0)" ::: "memory");
        }
    }
    __syncthreads();
}

__device__ __forceinline__ void transpose_item(const float* W, const float* g, int K, int N, bf16_t* WT, LAS float* scr, int item, int lane) {
    const int nblk = N / 32, kb = item / nblk, nb = item % nblk, k0 = 64 * kb, n0 = 32 * nb;
    float wv[32];
#pragma unroll
    for (int i = 0; i < 32; ++i) { const int kk = 2 * i + (lane >> 5); wv[i] = W[(size_t)(k0 + kk) * N + n0 + (lane & 31)]; }
    if (g) {
#pragma unroll
        for (int i = 0; i < 32; ++i) wv[i] *= g[k0 + 2 * i + (lane >> 5)]; }
#pragma unroll
    for (int i = 0; i < 32; ++i) scr[(2 * i + (lane >> 5)) * 33 + (lane & 31)] = wv[i];
    LDS_WAIT(); asm volatile("" ::: "memory");
    const int c = lane & 7;
#pragma unroll
    for (int j = 0; j < 4; ++j) { const int n = (lane >> 3) + 8 * j; const LAS float* s = scr + (8 * c) * 33 + n;
        u32x4 o; o.x = cvt_pk_bf16(s[0 * 33], s[1 * 33]); o.y = cvt_pk_bf16(s[2 * 33], s[3 * 33]); o.z = cvt_pk_bf16(s[4 * 33], s[5 * 33]); o.w = cvt_pk_bf16(s[6 * 33], s[7 * 33]);
        *(u32x4*)(WT + (size_t)(n0 + n) * K + k0 + 8 * c) = o; }
    LDS_WAIT(); asm volatile("" ::: "memory");
}
__device__ __forceinline__ void convert_pair(const float* W0, const float* g0, int K0, int N0, bf16_t* T0, const float* W1, const float* g1, int K1, int N1, bf16_t* T1, LAS unsigned char* lds, int gw, int ngw, int wave, int lane) {
    LAS float* scr = (LAS float*)(lds + wave * 16384);
    const int I0 = (K0 / 64) * (N0 / 32), I1 = (K1 / 64) * (N1 / 32);
    for (int it = gw; it < I0 + I1; it += ngw) { if (it < I0) transpose_item(W0, g0, K0, N0, T0, scr, it, lane); else transpose_item(W1, g1, K1, N1, T1, scr, it - I0, lane); }
    __syncthreads();
}
__device__ __forceinline__ void convert_mix(int L, const float* const* in, unsigned char* ws, LAS unsigned char* lds, int gw, int ngw, int wave, int lane) {
    const int i = L >> 1; const float* g = in[5] + (size_t)L * D; bf16_t* T = (bf16_t*)(ws + WS_WMIX);
    if ((L & 1) == 0) convert_pair(in[1] + (size_t)i * D * 3 * D, g, D, 3 * D, T, in[2] + (size_t)i * D * D, nullptr, D, D, T + (size_t)3 * D * D, lds, gw, ngw, wave, lane);
    else convert_pair(in[3] + (size_t)i * D * 6 * D, g, D, 6 * D, T, in[4] + (size_t)i * 2 * D * D, nullptr, 2 * D, D, T + (size_t)6 * D * D, lds, gw, ngw, wave, lane);
}
__device__ __forceinline__ void convert_mlp(int L, const float* const* in, unsigned char* ws, LAS unsigned char* lds, int gw, int ngw, int wave, int lane) {
    bf16_t* T = (bf16_t*)(ws + WS_WMLP);
    convert_pair(in[7] + (size_t)L * D * FF, in[6] + (size_t)L * D, D, FF, T, in[8] + (size_t)L * FF * D, nullptr, FF, D, T + (size_t)FF * D, lds, gw, ngw, wave, lane);
}
__device__ __forceinline__ void p0_rows(const float* x, bf16_t* hbf, bf16_t* lo, float* ssq, int gw, int ngw, int lane) {
    for (int m = gw; m < M / 2; m += ngw) { f32x4 v[2][4]; float s[2];
#pragma unroll
        for (int r = 0; r < 2; ++r) { const f32x4* xr = (const f32x4*)(x + (size_t)(2 * m + r) * D) + lane;
#pragma unroll
            for (int j = 0; j < 4; ++j) v[r][j] = xr[64 * j]; }
#pragma unroll
        for (int r = 0; r < 2; ++r) { s[r] = 0.f;
#pragma unroll
            for (int j = 0; j < 4; ++j) s[r] += (v[r][j][0] * v[r][j][0] + v[r][j][1] * v[r][j][1]) + (v[r][j][2] * v[r][j][2] + v[r][j][3] * v[r][j][3]);
            s[r] = wave_sum(s[r]);
            u32x2* o8 = (u32x2*)(hbf + (size_t)(2 * m + r) * D) + lane; u32x2* l8 = (u32x2*)(lo + (size_t)(2 * m + r) * D) + lane;
#pragma unroll
            for (int j = 0; j < 4; ++j) { u32x2 w; w.x = cvt_pk_bf16(v[r][j][0], v[r][j][1]); w.y = cvt_pk_bf16(v[r][j][2], v[r][j][3]); o8[64 * j] = w;
                u32x2 d; d.x = cvt_pk_bf16(v[r][j][0] - bf_lo(w.x), v[r][j][1] - bf_hi(w.x)); d.y = cvt_pk_bf16(v[r][j][2] - bf_lo(w.y), v[r][j][3] - bf_hi(w.y)); l8[64 * j] = d; }
            if (lane < 16) ssq[(size_t)(2 * m + r) * 16 + lane] = lane == 0 ? s[r] : 0.f; } }
}
__device__ __forceinline__ void final_rows(float* out, const float* ssq, const float* gf, int gw, int ngw, int lane) {
    const f32x4* gr = (const f32x4*)gf + lane; f32x4 gv[4];
#pragma unroll
    for (int j = 0; j < 4; ++j) gv[j] = gr[64 * j];
    for (int m = gw; m < M / 2; m += ngw) { f32x4 v[2][4]; float s[2];
#pragma unroll
        for (int r = 0; r < 2; ++r) { s[r] = ssq[(size_t)(2 * m + r) * 16 + (lane & 15)]; const f32x4* xr = (const f32x4*)(out + (size_t)(2 * m + r) * D) + lane;
#pragma unroll
            for (int j = 0; j < 4; ++j) v[r][j] = xr[64 * j]; }
#pragma unroll
        for (int r = 0; r < 2; ++r) { float t = s[r]; t += __shfl_xor(t, 1); t += __shfl_xor(t, 2); t += __shfl_xor(t, 4); t += __shfl_xor(t, 8);
            const float rr = rinv_of(t); f32x4* xr = (f32x4*)(out + (size_t)(2 * m + r) * D) + lane;
#pragma unroll
            for (int j = 0; j < 4; ++j) xr[64 * j] = v[r][j] * rr * gv[j]; } }
}
__device__ __forceinline__ void ret_scan(bf16_t* VS, int gtid, int gthreads) {
    for (int g = gtid; g < BATCH * RH * RDV * 32; g += gthreads) { const int bh = g >> 14, rem = g & 16383, e = rem >> 5, dg = rem & 31, h = bh & 3;
        const float dec = __builtin_amdgcn_exp2f(256.f * lg2gamma(h));
        bf16_t* p = VS + (size_t)bh * 16 * VS_P + (size_t)e * 512 + 256 + dg * 8; float st[8];
#pragma unroll
        for (int k = 0; k < 8; ++k) st[k] = 0.f;
        u32x4 w[16];
#pragma unroll
        for (int N = 0; N < 16; ++N) w[N] = *(const u32x4*)(p + (size_t)N * VS_P);
#pragma unroll
        for (int N = 0; N < 16; ++N) { u32x4 o; o.x = cvt_pk_bf16(st[0], st[1]); o.y = cvt_pk_bf16(st[2], st[3]); o.z = cvt_pk_bf16(st[4], st[5]); o.w = cvt_pk_bf16(st[6], st[7]);
            *(u32x4*)(p + (size_t)N * VS_P) = o;
            st[0] = dec * st[0] + bf_lo(w[N].x); st[1] = dec * st[1] + bf_hi(w[N].x); st[2] = dec * st[2] + bf_lo(w[N].y); st[3] = dec * st[3] + bf_hi(w[N].y);
            st[4] = dec * st[4] + bf_lo(w[N].z); st[5] = dec * st[5] + bf_hi(w[N].z); st[6] = dec * st[6] + bf_lo(w[N].w); st[7] = dec * st[7] + bf_hi(w[N].w); } }
}
__device__ __forceinline__ void sb_attn_simple(const bf16_t* Q, const bf16_t* K, const bf16_t* V, bf16_t* O, int gw, int ngw, int lane) {
    for (int task = gw; task < BATCH * SBH * (SEQ / 64); task += ngw) {
        const int bh = task >> 6, qb = task & 63, b = bh >> 4, h = bh & 15, q0 = qb * 64, t = q0 + lane;
        const size_t rowoff = ((size_t)b * SEQ + t) * D + h * SBD;
        float q[64], o[64];
#pragma unroll
        for (int i = 0; i < 8; ++i) { const u32x4 w = *(const u32x4*)(Q + rowoff + i * 8); q[8 * i + 0] = bf_lo(w.x); q[8 * i + 1] = bf_hi(w.x); q[8 * i + 2] = bf_lo(w.y); q[8 * i + 3] = bf_hi(w.y);
            q[8 * i + 4] = bf_lo(w.z); q[8 * i + 5] = bf_hi(w.z); q[8 * i + 6] = bf_lo(w.w); q[8 * i + 7] = bf_hi(w.w); }
#pragma unroll
        for (int i = 0; i < 64; ++i) o[i] = 0.f;
        float carry = 0.f;
        const bf16_t* Kb = K + (size_t)b * SEQ * D + h * SBD; const bf16_t* Vb = V + (size_t)b * SEQ * D + h * SBD;
        for (int s = q0 + 62; s >= 0; --s) {
            const u32x4* kr = (const u32x4*)(Kb + (size_t)s * D); float z0 = 0.f, z1 = 0.f;
#pragma unroll
            for (int i = 0; i < 8; ++i) { const u32x4 w = kr[i];
                z0 += q[8 * i + 0] * bf_lo(w.x); z1 += q[8 * i + 1] * bf_hi(w.x); z0 += q[8 * i + 2] * bf_lo(w.y); z1 += q[8 * i + 3] * bf_hi(w.y);
                z0 += q[8 * i + 4] * bf_lo(w.z); z1 += q[8 * i + 5] * bf_hi(w.z); z0 += q[8 * i + 6] * bf_lo(w.w); z1 += q[8 * i + 7] * bf_hi(w.w); }
            const float z = z0 + z1;
            const float l = __builtin_amdgcn_logf(1.f + __builtin_amdgcn_exp2f(-fabsf(z)));
            const float lk = -(fmaxf(z, 0.f) + l);
            const bool valid = s < t;
            const float a = valid ? __builtin_amdgcn_exp2f((z + lk) + carry) : 0.f;
            carry += valid ? lk : 0.f;
            const u32x4* vr = (const u32x4*)(Vb + (size_t)s * D);
#pragma unroll
            for (int i = 0; i < 8; ++i) { const u32x4 w = vr[i];
                o[8 * i + 0] += a * bf_lo(w.x); o[8 * i + 1] += a * bf_hi(w.x); o[8 * i + 2] += a * bf_lo(w.y); o[8 * i + 3] += a * bf_hi(w.y);
                o[8 * i + 4] += a * bf_lo(w.z); o[8 * i + 5] += a * bf_hi(w.z); o[8 * i + 6] += a * bf_lo(w.w); o[8 * i + 7] += a * bf_hi(w.w); }
            if (__all(carry < -152.f)) break;
        }
#pragma unroll
        for (int i = 0; i < 8; ++i) { u32x4 w; w.x = cvt_pk_bf16(o[8 * i + 0], o[8 * i + 1]); w.y = cvt_pk_bf16(o[8 * i + 2], o[8 * i + 3]); w.z = cvt_pk_bf16(o[8 * i + 4], o[8 * i + 5]); w.w = cvt_pk_bf16(o[8 * i + 6], o[8 * i + 7]);
            *(u32x4*)(O + rowoff + i * 8) = w; }
    }
}


typedef float f32x16 __attribute__((ext_vector_type(16)));
typedef short v4i16_t __attribute__((ext_vector_type(4)));
__device__ __forceinline__ v4i16_t vtr(const LAS unsigned char* p) { return __builtin_amdgcn_ds_read_tr16_b64_v4i16((LAS v4i16_t*)p); }
__device__ __forceinline__ float lane_partner(float mine) {
    const unsigned m = __float_as_uint(mine); const auto rr = __builtin_amdgcn_permlane32_swap(m, m, false, false); return __uint_as_float(rr[0] ^ rr[1] ^ m);
}
template <bool DIAG> __device__ __forceinline__ void sb_tile_math(float (&zz)[32], float& carry, int qlim, int hi, float m0) {
    float lk[32];
#pragma unroll
    for (int n = 0; n < 32; ++n) { const float z = zz[n];
        const float l = __builtin_amdgcn_logf(1.f + __builtin_amdgcn_exp2f(-fabsf(z)));
        float k = -(fmaxf(z, 0.f) + l), s = z + k;
        if (DIAG) { const bool v = ((n & 3) + 8 * ((n & 15) >> 2) + 32 * (n >> 4)) < qlim; k = v ? k : 0.f; s = v ? s : -INFINITY; }
        lk[n] = k; zz[n] = s; }
    float W = 0.f, off[8];
#pragma unroll
    for (int i = 7; i >= 0; --i) { const float t = ((lk[4 * i + 3] + lk[4 * i + 2]) + lk[4 * i + 1]) + lk[4 * i]; const float other = lane_partner(t); off[i] = carry + (W + m0 * other); W += t + other; }
    carry += W;
#pragma unroll
    for (int i = 0; i < 8; ++i) { const float bs = off[i], a = lk[4 * i + 3], b = a + lk[4 * i + 2], c = b + lk[4 * i + 1];
        zz[4 * i + 3] = __builtin_amdgcn_exp2f(zz[4 * i + 3] + bs); zz[4 * i + 2] = __builtin_amdgcn_exp2f(zz[4 * i + 2] + (bs + a));
        zz[4 * i + 1] = __builtin_amdgcn_exp2f(zz[4 * i + 1] + (bs + b)); zz[4 * i] = __builtin_amdgcn_exp2f(zz[4 * i] + (bs + c)); }
}
__device__ __forceinline__ void sb_load_tile(bf16x8 (&kf)[8], u32x4 (&vv)[8], const bf16_t* Kh, const bf16_t* Vh, int j, int lane) {
    const int r32 = lane & 31, hi = lane >> 5;
    const bf16_t* kp = Kh + (size_t)(64 * j + r32) * D + 8 * hi;
#pragma unroll
    for (int d0 = 0; d0 < 4; ++d0) { kf[2 * d0] = *(const bf16x8*)(kp + 16 * d0); kf[2 * d0 + 1] = *(const bf16x8*)(kp + (size_t)32 * D + 16 * d0); }
    const bf16_t* vp = Vh + (size_t)(64 * j + (lane >> 2)) * D + (lane & 3) * 8;
#pragma unroll
    for (int w = 0; w < 8; ++w) vv[w] = *(const u32x4*)(vp + (size_t)(16 * (w & 3)) * D + (w >> 2) * 32);
}
template <bool DIAG> __device__ __forceinline__ void sb_tile(const bf16x8 (&kf)[8], const bf16x8 (&qr)[4], const LAS unsigned char* vp0, f32x16& o0, f32x16& o1, float& carry, int qlim, int hi, float m0) {
    f32x16 p0 = {0.f, 0.f, 0.f, 0.f, 0.f, 0.f, 0.f, 0.f, 0.f, 0.f, 0.f, 0.f, 0.f, 0.f, 0.f, 0.f}, p1 = p0;
#pragma unroll
    for (int d0 = 0; d0 < 4; ++d0) { p0 = __builtin_amdgcn_mfma_f32_32x32x16_bf16(kf[2 * d0], qr[d0], p0, 0, 0, 0); p1 = __builtin_amdgcn_mfma_f32_32x32x16_bf16(kf[2 * d0 + 1], qr[d0], p1, 0, 0, 0); }
    float zz[32];
#pragma unroll
    for (int r = 0; r < 16; ++r) { zz[r] = p0[r]; zz[16 + r] = p1[r]; }
    sb_tile_math<DIAG>(zz, carry, qlim, hi, m0);
    u32x4 pw[4];
#pragma unroll
    for (int k = 0; k < 4; ++k) { pw[k].x = cvt_pk_bf16(zz[8 * k + 0], zz[8 * k + 1]); pw[k].y = cvt_pk_bf16(zz[8 * k + 2], zz[8 * k + 3]); pw[k].z = cvt_pk_bf16(zz[8 * k + 4], zz[8 * k + 5]); pw[k].w = cvt_pk_bf16(zz[8 * k + 6], zz[8 * k + 7]); }
#pragma unroll
    for (int d0 = 0; d0 < 2; ++d0)
#pragma unroll
        for (int ks = 0; ks < 4; ++ks) { const v4i16_t lo = vtr(vp0 + d0 * 4096 + ks * 1024), hh = vtr(vp0 + d0 * 4096 + ks * 1024 + 512);
            const bf16x8 vf = (bf16x8){lo[0], lo[1], lo[2], lo[3], hh[0], hh[1], hh[2], hh[3]};
            if (d0 == 0) o0 = __builtin_amdgcn_mfma_f32_32x32x16_bf16(__builtin_bit_cast(bf16x8, pw[ks]), vf, o0, 0, 0, 0);
            else o1 = __builtin_amdgcn_mfma_f32_32x32x16_bf16(__builtin_bit_cast(bf16x8, pw[ks]), vf, o1, 0, 0, 0); }
}
__device__ __forceinline__ void sb_attn_mfma(const bf16_t* Q, const bf16_t* K, const bf16_t* V, bf16_t* O, LAS unsigned char* lds, int gw, int ngw, int wave, int lane_in) {
    LAS unsigned char* vb = lds + wave * 8192;
    for (int unit = gw; unit < BATCH * SBH * (SEQ / 32); unit += ngw) {
        int lane = lane_in; asm volatile("" : "+v"(lane));
        const int r32 = lane & 31, hi = lane >> 5; const float m0 = hi == 0 ? 1.f : 0.f;
        const LAS unsigned char* vp0 = vb + ((lane >> 4) & 1) * 32 + (lane & 3) * 8 + (4 * hi + ((lane & 15) >> 2)) * 64;
        LAS unsigned char* vw = vb + lane * 16;
        const int bh = unit >> 7, qb = unit & 127, b = bh >> 4, h = bh & 15, qs = qb * 32, jd = qs >> 6;
        const bf16_t* Qw = Q + ((size_t)b * SEQ + qs + r32) * D + h * SBD + hi * 8;
        bf16x8 qr[4];
#pragma unroll
        for (int d0 = 0; d0 < 4; ++d0) qr[d0] = *(const bf16x8*)(Qw + d0 * 16);
        const bf16_t* Kh = K + (size_t)b * SEQ * D + h * SBD; const bf16_t* Vh = V + (size_t)b * SEQ * D + h * SBD;
        bf16x8 kc[8], kn[8]; u32x4 vn[8];
        int j = jd;
        sb_load_tile(kc, vn, Kh, Vh, j, lane);
#pragma unroll
        for (int w = 0; w < 8; ++w) *(LAS u32x4*)(vw + w * 1024) = vn[w];
        f32x16 o0 = {0.f, 0.f, 0.f, 0.f, 0.f, 0.f, 0.f, 0.f, 0.f, 0.f, 0.f, 0.f, 0.f, 0.f, 0.f, 0.f}, o1 = o0; float carry = 0.f;
        if (j > 0) sb_load_tile(kn, vn, Kh, Vh, j - 1, lane);
        sb_tile<true>(kc, qr, vp0, o0, o1, carry, (qs & 63) + r32 - 4 * hi, hi, m0);
        while (j > 0 && !__all(carry < -152.f)) {
#pragma unroll
            for (int w = 0; w < 8; ++w) *(LAS u32x4*)(vw + w * 1024) = vn[w];
#pragma unroll
            for (int i = 0; i < 8; ++i) kc[i] = kn[i];
            --j;
            if (j > 0) sb_load_tile(kn, vn, Kh, Vh, j - 1, lane);
            sb_tile<false>(kc, qr, vp0, o0, o1, carry, 0, hi, m0);
        }
        bf16_t* Ow = O + ((size_t)b * SEQ + qs + 4 * hi) * D + h * SBD + r32;
#pragma unroll
        for (int r = 0; r < 16; ++r) { const int q = (r & 3) + 8 * (r >> 2); const unsigned w0 = cvt_pk_bf16(o0[r], o1[r]);
            Ow[(size_t)q * D] = (bf16_t)(w0 & 0xffffu); Ow[(size_t)q * D + 32] = (bf16_t)(w0 >> 16); }
    }
}

#ifndef PROBE_SEL
#define PROBE_SEL -1
#endif
#ifndef PROBE_BLOCK
#define PROBE_BLOCK 0
#endif
struct Probe { unsigned long long last, sel, tb; };
#if PROBE_SEL >= 0
#define PH_END(k) do { const unsigned long long now_ = __builtin_amdgcn_s_memrealtime(); if ((k) == PROBE_SEL) pr.sel += now_ - pr.last; pr.last = now_; } while (0)
#define GRID_BAR() do { pr.tb = __builtin_amdgcn_s_memrealtime(); xcd_barrier(bar); if (PROBE_SEL == 13) pr.sel += __builtin_amdgcn_s_memrealtime() - pr.tb; } while (0)
#else
#define PH_END(k) do { } while (0)
#define GRID_BAR() xcd_barrier(bar)
#endif
struct Args { const float* in[10]; float* out; unsigned char* ws; };
struct Ctx { LAS unsigned char* lds; unsigned char* ws; const float* const* in; float* out; int G, bx, gw, ngw, wave, lane, tid; };

template <int L> __device__ __forceinline__ void layer(const Ctx& c, const XcdBarrier& bar, Probe& pr) {
    LAS unsigned char* lds = c.lds; unsigned char* ws = c.ws; const int G = c.G, bx = c.bx;
    const float* x = c.in[0]; float* out = c.out;
    float* ssq = (float*)(ws + WS_SSQ); float* GN = (float*)(ws + WS_GN);
    bf16_t* hbf = (bf16_t*)(ws + WS_HBF); bf16_t* wmix = (bf16_t*)(ws + WS_WMIX); bf16_t* wmlp = (bf16_t*)(ws + WS_WMLP);
    bf16_t* lo = (bf16_t*)out;
    bf16_t* lo_alt = (bf16_t*)(ws + WS_LOALT);
    if constexpr ((L & 1) == 0) {
        bf16_t* Qb = (bf16_t*)(ws + WS_Q); bf16_t* Kb = (bf16_t*)(ws + WS_K); bf16_t* Vb = (bf16_t*)(ws + WS_V);
        { pg8::StdOrder S; S.init(M, 3 * D, G, bx, hbf, wmix, D, D); EpiQKV E{Qb, ssq};
          pg8::gemm_phase<EpiQKV, pg8::StdOrder, D, D, D, true>(lds, S, E); }
        GRID_BAR(); PH_END(1);
        sb_attn_mfma(Qb, Kb, Vb, Qb, lds, c.gw, c.ngw, c.wave, c.lane);
        GRID_BAR(); PH_END(2);
        convert_mlp(L, c.in, ws, lds, c.gw, c.ngw, c.wave, c.lane);
        { pg8::StdOrder S; S.init(M, D, G, bx, Qb, wmix + (size_t)3 * D * D, D, D); EpiResT<false> E{hbf, lo, lo, out, ssq};
          pg8::gemm_phase<EpiResT<false>, pg8::StdOrder, D, D, D, false>(lds, S, E); }
        GRID_BAR(); PH_END(3);
    } else {
        bf16_t* SQ = (bf16_t*)(ws + WS_SQ); bf16_t* VS = (bf16_t*)(ws + WS_VS); bf16_t* KN = (bf16_t*)(ws + WS_KN); bf16_t* Y = (bf16_t*)(ws + WS_Y);
        { pg8::StdOrder S; S.init(M, 2 * D, G, bx, hbf, wmix, D, D); EpiRetQK E{SQ, KN, ssq};
          pg8::gemm_phase<EpiRetQK, pg8::StdOrder, D, D, D, true>(lds, S, E); }
        { pg8::StdOrder S; S.init(2 * D, M, G, bx, wmix + (size_t)2 * D * D, hbf, D, D); EpiRetVt E{VS, ssq};
          pg8::gemm_phase<EpiRetVt, pg8::StdOrder, D, D, D, true>(lds, S, E); }
        GRID_BAR(); PH_END(4);
        { KVOrder S{G, bx, (const char*)VS, (const char*)SQ}; EpiKV E{VS};
          pg8::gemm_phase<EpiKV, KVOrder, 512, 512, 256, true>(lds, S, E); }
        { SOrder S{G, bx, (const char*)SQ, (const char*)KN}; EpiS E{SQ};
          pg8::gemm_phase<EpiS, SOrder, 512, 1024, 256, true>(lds, S, E); }
        GRID_BAR(); PH_END(5);
        ret_scan(VS, bx * NWAVES * 64 + c.tid, G * NWAVES * 64);
        GRID_BAR(); PH_END(6);
        { OOrder S{G, bx, (const char*)SQ, (const char*)VS}; EpiO E{SQ, KN, GN};
          pg8::gemm_phase<EpiO, OOrder, 512, 512, 512, true>(lds, S, E); }
        GRID_BAR(); PH_END(7);
        { pg8::StdOrder S; S.init(M, 2 * D, G, bx, hbf, wmix + (size_t)4 * D * D, D, D); EpiG E{SQ, KN, GN, ssq, Y};
          pg8::gemm_phase<EpiG, pg8::StdOrder, D, D, D, true>(lds, S, E); }
        GRID_BAR(); PH_END(8);
        convert_mlp(L, c.in, ws, lds, c.gw, c.ngw, c.wave, c.lane);
        { pg8::StdOrder S; S.init(M, D, G, bx, Y, wmix + (size_t)6 * D * D, 2 * D, 2 * D); EpiResT<false> E{hbf, lo, (L == NLAYER - 1) ? lo_alt : lo, out, ssq};
          pg8::gemm_phase<EpiResT<false>, pg8::StdOrder, 2 * D, 2 * D, 2 * D, false>(lds, S, E); }
        GRID_BAR(); PH_END(9);
    }
    bf16_t* U = (bf16_t*)(ws + WS_U);
    { pg8::StdOrder S; S.init(M, FF, G, bx, hbf, wmlp, D, D); EpiUp E{U, ssq};
      pg8::gemm_phase<EpiUp, pg8::StdOrder, D, D, D, true>(lds, S, E); }
    GRID_BAR(); PH_END(10);
    if constexpr (L + 1 < NLAYER) convert_mix(L + 1, c.in, ws, lds, c.gw, c.ngw, c.wave, c.lane);
    if constexpr (L == NLAYER - 1) { pg8::StdOrder S; S.init(M, D, G, bx, U, wmlp + (size_t)FF * D, FF, FF); EpiResT<true> E{hbf, lo_alt, lo_alt, out, ssq};
      pg8::gemm_phase<EpiResT<true>, pg8::StdOrder, FF, FF, FF, false>(lds, S, E); }
    else { pg8::StdOrder S; S.init(M, D, G, bx, U, wmlp + (size_t)FF * D, FF, FF); EpiResT<false> E{hbf, lo, lo, out, ssq};
      pg8::gemm_phase<EpiResT<false>, pg8::StdOrder, FF, FF, FF, false>(lds, S, E); }
    GRID_BAR(); PH_END(11);
}

__global__ void __launch_bounds__(NWAVES * 64, 2) trunk_fwd(Args args) {
    extern __shared__ __attribute__((aligned(16))) unsigned char lds_raw[];
    LAS unsigned char* lds = (LAS unsigned char*)lds_raw;
    volatile LAS unsigned* MISC = (volatile LAS unsigned*)(lds + MISC_OFF);
    const int tid = threadIdx.x, lane = tid & 63, wave = __builtin_amdgcn_readfirstlane(tid >> 6);
    const int G = gridDim.x, bx = blockIdx.x;
    const int gw = bx * NWAVES + wave, ngw = G * NWAVES;
    unsigned char* ws = args.ws;
    unsigned* ctl = (unsigned*)(ws + WS_CTL);
    for (int u = tid; u < (LDS_BYTES - LDSCTL_OFF) / 4; u += NWAVES * 64) ((LAS unsigned*)(lds + LDSCTL_OFF))[u] = 0u;
    __syncthreads();
    const XcdBarrier bar = xcd_barrier_post(ctl + 4096, MISC + 8);
    const Ctx c{lds, ws, args.in, args.out, G, bx, gw, ngw, wave, lane, tid};
    Probe pr{0ull, 0ull, 0ull};
#if PROBE_SEL >= 0
    pr.last = __builtin_amdgcn_s_memrealtime();
#endif

    p0_rows(args.in[0], (bf16_t*)(ws + WS_HBF), (bf16_t*)args.out, (float*)(ws + WS_SSQ), gw, ngw, lane);
    convert_mix(0, args.in, ws, lds, gw, ngw, wave, lane);
    GRID_BAR(); PH_END(0);
    layer<0>(c, bar, pr); layer<1>(c, bar, pr); layer<2>(c, bar, pr); layer<3>(c, bar, pr);
    { int lane_f = lane; asm volatile("" : "+v"(lane_f));
      final_rows(args.out, (const float*)(ws + WS_SSQ), args.in[9], gw, ngw, lane_f); }
#if PROBE_SEL >= 0
    PH_END(12);
    if (bx == PROBE_BLOCK && tid == 0) { const unsigned long long t0 = __builtin_amdgcn_s_memrealtime(); while (__builtin_amdgcn_s_memrealtime() - t0 < 8ull * pr.sel) __builtin_amdgcn_s_sleep(8); }
#endif
}

extern "C" void kernel_launch(void* const* d_in, const int* in_sizes, int n_in, void* d_out, int out_size, void* d_ws, size_t ws_size, hipStream_t stream) {
    static int grid = 0;
    if (grid == 0) {
        if (n_in != 10 || in_sizes[0] != M * D || out_size != M * D || ws_size < WS_END) { fprintf(stderr, "kernel_launch: unexpected shapes / workspace (%d inputs, ws %zu < %zu)\n", n_in, ws_size, (size_t)WS_END); grid = -1; return; }
        int dev = 0, cus = 0, per_cu = 0;
        if (hipGetDevice(&dev) != hipSuccess || hipDeviceGetAttribute(&cus, hipDeviceAttributeMultiprocessorCount, dev) != hipSuccess) { grid = -1; return; }
        if (hipFuncSetAttribute((const void*)trunk_fwd, hipFuncAttributeMaxDynamicSharedMemorySize, LDS_BYTES) != hipSuccess) { fprintf(stderr, "kernel_launch: hipFuncSetAttribute failed\n"); grid = -1; return; }
        if (hipOccupancyMaxActiveBlocksPerMultiprocessor(&per_cu, (const void*)trunk_fwd, NWAVES * 64, LDS_BYTES) != hipSuccess || per_cu < 1) fprintf(stderr, "kernel_launch: occupancy query reports %d\n", per_cu);
        (void)hipGetLastError();
        grid = cus;
    }
    if (grid < 0) return;
    if (hipMemsetAsync((char*)d_ws + WS_CTL, 0, CTL_ZERO_BYTES, stream) != hipSuccess) return;
    Args a{};
    for (int i = 0; i < 10; ++i) a.in[i] = (const float*)d_in[i];
    a.out = (float*)d_out; a.ws = (unsigned char*)d_ws;
    hipLaunchKernelGGL(trunk_fwd, dim3(grid), dim3(NWAVES * 64), LDS_BYTES, stream, a);
}
```

```cpp
#include <hip/hip_runtime.h>
#include <cstdio>
#include <cstdint>

#define PG8_LAS __attribute__((address_space(3)))
#define GAS __attribute__((address_space(1)))
#define LAS __attribute__((address_space(3)))
typedef unsigned short bf16_t;
typedef short bf16x8 __attribute__((ext_vector_type(8)));
typedef float f32x4 __attribute__((ext_vector_type(4)));
typedef float f32x2 __attribute__((ext_vector_type(2)));
typedef unsigned u32x4 __attribute__((ext_vector_type(4)));
typedef unsigned u32x2 __attribute__((ext_vector_type(2)));

constexpr int BATCH = 4, SEQ = 4096, D = 1024, FF = 4096, NLAYER = 4;
constexpr int M = BATCH * SEQ;
constexpr int SBH = 16, SBD = 64;
constexpr int RH = 4, RDK = 256, RDV = 512, RC = 256, RNC = SEQ / RC;
constexpr int NPROB = BATCH * RH * RNC;
constexpr float RMS_EPS = 1e-6f, GN_EPS = 1e-6f;
constexpr float C2 = 0.18033688011112042f;
constexpr float L2B127 = 0.10462765653188542f;
constexpr float INV2PI = 0.15915494309189535f;
constexpr float LOG2E = 1.4426950408889634f;
__device__ __forceinline__ float lg2gamma(int h) { return h == 0 ? -0.04580368961312479f : (h == 1 ? -0.02272007650008353f : (h == 2 ? -0.011315313227834146f : -0.005646563141142063f)); }

constexpr size_t MiB = 1u << 20;
constexpr size_t WS_CTL = 0, CTL_ZERO_BYTES = 1 * MiB;
constexpr size_t WS_SSQ = 1 * MiB;
constexpr size_t WS_GN = 2 * MiB;
constexpr size_t WS_HBF = 6 * MiB;
constexpr size_t WS_WMIX = 38 * MiB;
constexpr size_t WS_SCR = 54 * MiB;
constexpr size_t WS_Q = WS_SCR, WS_K = WS_SCR + 32 * MiB, WS_V = WS_SCR + 64 * MiB;
constexpr size_t WS_SQ = WS_SCR;
constexpr size_t WS_VS = WS_SCR + 64 * MiB;
constexpr size_t WS_KN = WS_SCR + 192 * MiB;
constexpr size_t WS_Y = WS_VS;
constexpr size_t WS_U = WS_SCR;
constexpr size_t WS_WMLP = WS_SCR + 192 * MiB;
constexpr size_t WS_LOALT = WS_SCR + 128 * MiB;
constexpr size_t WS_END = WS_SCR + 224 * MiB;
constexpr size_t SQ_P = 256 * 512, VS_P = 512 * 512;

constexpr int RING_BYTES = 131072, LDSCTL_OFF = RING_BYTES, MISC_OFF = LDSCTL_OFF + 320, LDS_BYTES = 147456;
constexpr int NWAVES = 8;

__device__ __forceinline__ unsigned cvt_pk_bf16(float lo, float hi) { unsigned r; asm volatile("v_cvt_pk_bf16_f32 %0, %1, %2" : "=v"(r) : "v"(lo), "v"(hi)); return r; }
__device__ __forceinline__ float bf_lo(unsigned w) { return __uint_as_float(w << 16); }
__device__ __forceinline__ float bf_hi(unsigned w) { return __uint_as_float(w & 0xffff0000u); }
__device__ __forceinline__ u32x4 pack8(f32x4 a, f32x4 b) { u32x4 w; w.x = cvt_pk_bf16(a[0], a[1]); w.y = cvt_pk_bf16(a[2], a[3]); w.z = cvt_pk_bf16(b[0], b[1]); w.w = cvt_pk_bf16(b[2], b[3]); return w; }
__device__ __forceinline__ float wave_sum(float v) {
#pragma unroll
    for (int o = 1; o < 64; o <<= 1) v += __shfl_xor(v, o);
    return v;
}
__device__ __forceinline__ float rinv_of(float ss) { return 1.0f / sqrtf(ss * (1.0f / D) + RMS_EPS); }
#define LDS_WAIT() asm volatile("s_waitcnt lgkmcnt(0)" ::: "memory")
#define VM_WAIT() asm volatile("s_waitcnt vmcnt(0)" ::: "memory")

__device__ __forceinline__ void rinv_rows(const float* ssq, int rowbase, int fq, float (&ri)[2][4]);
namespace pg8 {
constexpr int BM = 256, BK = 64, HALF = 128, HTB = HALF * BK * 2, STAGE_BYTES = 8 * HTB, NXCD = 8, WGM = 8;
__host__ __device__ __forceinline__ int lds_byte(int r, int c) { const int st = (r >> 4) * 2 + (c >> 5), rr = r & 15, cc = c & 31, ob = rr * 64 + cc * 2; return st * 1024 + (ob ^ (((ob >> 9) & 1) << 5)); }
__host__ __device__ __forceinline__ void stage_rc(int b, int& R, int& C) { const int st = b / 1024, sb = b % 1024, swz = sb ^ (((sb >> 9) & 1) << 5); R = (st >> 1) * 16 + swz / 64; C = (st & 1) * 32 + (swz % 64) / 2; }
__host__ __device__ __forceinline__ int perm32(int rho) { const int n = rho >> 4, i = rho & 15; return 8 * (i >> 2) + 4 * n + (i & 3); }

struct Unit { int pm, pn, p; const char* a; const char* b; };

struct StdOrder {
    int nM, nN, nwg, G, c; const char* A; const char* B; size_t tA, tB;
    __device__ __forceinline__ void init(int Mr, int Nc, int G_, int c_, const void* A_, const void* B_, int lda, int ldb) { nM = Mr / BM; nN = Nc / BM; nwg = nM * nN; G = G_; c = c_; A = (const char*)A_; B = (const char*)B_; tA = (size_t)BM * lda * 2; tB = (size_t)BM * ldb * 2; }
    __device__ __forceinline__ bool next(int i, Unit& u) const {
        const long L = (long)i * G + c; if (L >= nwg) return false;
        int wgid = (int)L; { const int q = nwg / NXCD, r = nwg % NXCD, xcd = wgid % NXCD, off = wgid / NXCD; wgid = (xcd < r ? xcd * (q + 1) : r * (q + 1) + (xcd - r) * q) + off; }
        const int nig = WGM * nN, gid = wgid / nig, fm = gid * WGM, gsz = (nM - fm) < WGM ? (nM - fm) : WGM;
        u.pm = fm + ((wgid % nig) % gsz); u.pn = (wgid % nig) / gsz; u.p = 0; u.a = A + (size_t)u.pm * tA; u.b = B + (size_t)u.pn * tB; return true;
    }
};

template <class Epi, class Sched, int LDA, int LDB, int KD, bool ALIGN_EPI>
__device__ __forceinline__ void gemm_phase(PG8_LAS unsigned char* lds, const Sched& S, const Epi& E) {
    int tid = threadIdx.x; asm volatile("" : "+v"(tid));
    const int wid = __builtin_amdgcn_readfirstlane(tid >> 6), lane = tid & 63, wr = wid >> 2, wc = wid & 3, fr = lane & 15, fq = lane >> 4;
    constexpr int nt = KD / BK;
    static_assert(KD % 128 == 0 && KD >= 256, "K multiple of 128, >= 256");
    unsigned voffA[2], voffB[2];
#pragma unroll
    for (int i = 0; i < 2; ++i) { int R, C; stage_rc(tid * 16 + i * 8192, R, C); const int Rb = (R & ~31) + perm32(R & 31);
        voffA[i] = (unsigned)(R * LDA + C) * 2u; voffB[i] = (unsigned)(Rb * LDB + C) * 2u; }
    constexpr size_t kstep = (size_t)(BK * 2), hstepA = (size_t)HALF * LDA * 2, hstepB = (size_t)HALF * LDB * 2;
    const unsigned ldsw = (unsigned)wid * 1024u;
    const int aoff = lds_byte(wr * 64 + fr, fq * 8), boff = lds_byte(wc * 32 + fr, fq * 8);
#define PG8_SA(b, h) (((b) * 2 + (h)) * HTB)
#define PG8_SB(b, h) ((4 + (b) * 2 + (h)) * HTB)
#define PG8_STAGE(bufoff, gbase, voff) do { _Pragma("unroll") for (int _i = 0; _i < 2; ++_i) \
        __builtin_amdgcn_global_load_lds((const unsigned*)((const char*)(gbase) + (voff)[_i]), (PG8_LAS unsigned*)(lds + (bufoff) + ldsw + _i * 8192), 16, 0, 0); } while (0)
#define PG8_LDA(dst, b, h) do { _Pragma("unroll") for (int m = 0; m < 4; ++m) _Pragma("unroll") for (int k = 0; k < 2; ++k) dst[m][k] = *(const PG8_LAS bf16x8*)(lds + PG8_SA(b, h) + aoff + m * 2048 + k * 1024); } while (0)
#define PG8_LDB(dst, b, h) do { _Pragma("unroll") for (int n = 0; n < 2; ++n) _Pragma("unroll") for (int k = 0; k < 2; ++k) dst[n][k] = *(const PG8_LAS bf16x8*)(lds + PG8_SB(b, h) + boff + n * 2048 + k * 1024); } while (0)
#define PG8_MMA(ai, bj, At, Bt) do { __builtin_amdgcn_s_setprio(1); _Pragma("unroll") for (int m = 0; m < 4; ++m) _Pragma("unroll") for (int n = 0; n < 2; ++n) _Pragma("unroll") for (int k = 0; k < 2; ++k) \
        acc[ai][bj][m][n] = __builtin_amdgcn_mfma_f32_16x16x32_bf16(Bt[n][k], At[m][k], acc[ai][bj][m][n], 0, 0, 0); __builtin_amdgcn_s_setprio(0); } while (0)
#define PG8_WAIT_V(n) asm volatile("s_waitcnt vmcnt(" #n ")" ::: "memory")
#define PG8_WAIT_L(n) asm volatile("s_waitcnt lgkmcnt(" #n ")" ::: "memory")
#define PG8_BAR __builtin_amdgcn_s_barrier()
#define PG8_SCHED __builtin_amdgcn_sched_barrier(0)
    Unit cur, nxt; int ui = 0;
    if (!S.next(0, cur)) return;
    float ri[2][4];
    if constexpr (Epi::USES_RI) { int fr_ = fr, fq_ = fq; asm volatile("" : "+v"(fr_), "+v"(fq_)); ::rinv_rows(E.ssq, cur.pm * 256 + wr * 64 + fr_, fq_, ri); }
    f32x4 acc[2][2][4][2];
#pragma unroll
    for (int a = 0; a < 2; ++a)
#pragma unroll
        for (int b = 0; b < 2; ++b)
#pragma unroll
            for (int m = 0; m < 4; ++m)
#pragma unroll
                for (int n = 0; n < 2; ++n) acc[a][b][m][n] = (f32x4){0.f, 0.f, 0.f, 0.f};
    bf16x8 At[4][2], B0[2][2], B1[2][2];
    const char* cA = cur.a; const char* cB = cur.b;
    PG8_STAGE(PG8_SB(0, 0), cB, voffB); PG8_STAGE(PG8_SB(0, 1), cB + hstepB, voffB); PG8_STAGE(PG8_SA(0, 0), cA, voffA); PG8_STAGE(PG8_SA(0, 1), cA + hstepA, voffA);
    if (wr == 1) PG8_BAR;
    PG8_WAIT_V(2); PG8_BAR;
    PG8_STAGE(PG8_SB(1, 0), cB + kstep, voffB); PG8_STAGE(PG8_SA(1, 0), cA + kstep, voffA); PG8_STAGE(PG8_SB(1, 1), cB + hstepB + kstep, voffB);
    PG8_WAIT_V(6); PG8_BAR;
    for (;;) {
        const bool has_next = S.next(ui + 1, nxt);
        const char* nA = has_next ? nxt.a : cA; const char* nB = has_next ? nxt.b : cB;
#pragma nounroll
        for (int t = 0; t < nt; t += 2) {
            const bool last = (t == nt - 2);
            const char* a1 = cA + (size_t)(t + 1) * kstep;
            const char* a2 = last ? nA : cA + (size_t)(t + 2) * kstep; const char* b2 = last ? nB : cB + (size_t)(t + 2) * kstep;
            const char* a3 = a2 + kstep; const char* b3 = b2 + kstep;
            PG8_LDB(B0, 0, 0); PG8_LDB(B1, 0, 1); PG8_SCHED; PG8_LDA(At, 0, 0); PG8_STAGE(PG8_SA(1, 1), a1 + hstepA, voffA);
            PG8_WAIT_V(8); PG8_WAIT_L(0); PG8_BAR; PG8_MMA(0, 0, At, B0); PG8_MMA(0, 1, At, B1); PG8_BAR; PG8_SCHED;
            PG8_LDA(At, 0, 1); PG8_STAGE(PG8_SB(0, 0), b2, voffB); PG8_STAGE(PG8_SB(0, 1), b2 + hstepB, voffB); PG8_STAGE(PG8_SA(0, 0), a2, voffA);
            PG8_WAIT_V(8); PG8_WAIT_L(0); PG8_BAR; PG8_MMA(1, 0, At, B0); PG8_MMA(1, 1, At, B1); PG8_BAR; PG8_SCHED;
            PG8_LDB(B0, 1, 0); PG8_LDB(B1, 1, 1); PG8_SCHED; PG8_LDA(At, 1, 0); PG8_STAGE(PG8_SA(0, 1), a2 + hstepA, voffA);
            PG8_WAIT_V(8); PG8_WAIT_L(0); PG8_BAR; PG8_MMA(0, 0, At, B0); PG8_MMA(0, 1, At, B1); PG8_BAR; PG8_SCHED;
            PG8_LDA(At, 1, 1); PG8_STAGE(PG8_SB(1, 0), b3, voffB); PG8_STAGE(PG8_SB(1, 1), b3 + hstepB, voffB); PG8_STAGE(PG8_SA(1, 0), a3, voffA);
            PG8_WAIT_V(8); PG8_WAIT_L(0); PG8_BAR; PG8_MMA(1, 0, At, B0); PG8_MMA(1, 1, At, B1); PG8_BAR; PG8_SCHED;
        }
        if constexpr (ALIGN_EPI) { if (wr == 0) PG8_BAR; }
        E(acc, cur, has_next, nxt, ri, wr, wc, fr, fq);
        if (!has_next) break;
#pragma unroll
        for (int a = 0; a < 2; ++a)
#pragma unroll
            for (int b = 0; b < 2; ++b)
#pragma unroll
                for (int m = 0; m < 4; ++m)
#pragma unroll
                    for (int n = 0; n < 2; ++n) acc[a][b][m][n] = (f32x4){0.f, 0.f, 0.f, 0.f};
        cur = nxt; cA = nA; cB = nB; ++ui;
        if constexpr (ALIGN_EPI) { if (wr == 1) PG8_BAR; }
    }
    PG8_WAIT_V(0);
    if constexpr (!ALIGN_EPI) { if (wr == 0) PG8_BAR; }
    PG8_BAR;
#undef PG8_SA
#undef PG8_SB
#undef PG8_STAGE
#undef PG8_LDA
#undef PG8_LDB
#undef PG8_MMA
#undef PG8_WAIT_V
#undef PG8_WAIT_L
#undef PG8_BAR
#undef PG8_SCHED
}
typedef f32x4 Acc[2][2][4][2];
}
using pg8::Unit;

__device__ __forceinline__ void ri_issue(const float* ssq, int rowbase, int fq, f32x4 (&raw)[2][4]) {
#pragma unroll
    for (int ai = 0; ai < 2; ++ai)
#pragma unroll
        for (int m = 0; m < 4; ++m) raw[ai][m] = *(const f32x4*)(ssq + (size_t)(rowbase + ai * 128 + m * 16) * 16 + fq * 4);
}
__device__ __forceinline__ void ri_reduce(const f32x4 (&raw)[2][4], float (&ri)[2][4]) {
#pragma unroll
    for (int ai = 0; ai < 2; ++ai)
#pragma unroll
        for (int m = 0; m < 4; ++m) { const f32x4 v = raw[ai][m]; float s = (v[0] + v[1]) + (v[2] + v[3]); s += __shfl_xor(s, 16); s += __shfl_xor(s, 32); ri[ai][m] = rinv_of(s); }
}
__device__ __forceinline__ void rinv_rows(const float* ssq, int rowbase, int fq, float (&ri)[2][4]) { f32x4 raw[2][4]; ri_issue(ssq, rowbase, fq, raw); ri_reduce(raw, ri); }
__device__ __forceinline__ void rinv_cols(const float* ssq, int colbase  , int fr, int lane, float (&rc)[2][8]) {
    const int tok = colbase + 128 * (fr >> 3) + (fr & 7); const f32x4* p = (const f32x4*)(ssq + (size_t)tok * 16);
    const f32x4 a = p[0], b = p[1], c = p[2], d = p[3];
    const float s = (((a[0] + a[1]) + (a[2] + a[3])) + ((b[0] + b[1]) + (b[2] + b[3]))) + (((c[0] + c[1]) + (c[2] + c[3])) + ((d[0] + d[1]) + (d[2] + d[3])));
    const float r = rinv_of(s);
#pragma unroll
    for (int bj = 0; bj < 2; ++bj)
#pragma unroll
        for (int q = 0; q < 8; ++q) rc[bj][q] = __shfl(r, (lane & 48) | (bj * 8 + q));
}
__device__ __forceinline__ void sincos_rev(float ang, float& sn, float& cs) { float rev = ang * INV2PI; rev = __builtin_amdgcn_fractf(rev); sn = __builtin_amdgcn_sinf(rev); cs = __builtin_amdgcn_cosf(rev); }

struct EpiQKV { static constexpr bool PERM = true, USES_RI = true; bf16_t* q; const float* ssq;
    __device__ __forceinline__ void operator()(const pg8::Acc& acc, const Unit& u, bool has_next, const Unit& nxt, float (&ri)[2][4], int wr, int wc, int fr, int fq) const {
        asm volatile("" : "+v"(fr), "+v"(fq));
        const int t = u.pn >> 2; bf16_t* base = q + (size_t)t * ((WS_K - WS_Q) / 2); const float sc = t == 0 ? C2 : 1.f;
        const int row0 = u.pm * 256 + wr * 64 + fr, col0 = (u.pn & 3) * 256 + wc * 32 + 8 * fq;
        f32x4 nraw[2][4]; if (has_next) ri_issue(ssq, nxt.pm * 256 + wr * 64 + fr, fq, nraw);
#pragma unroll
        for (int ai = 0; ai < 2; ++ai)
#pragma unroll
            for (int m = 0; m < 4; ++m) { const float s = ri[ai][m] * sc; bf16_t* rowp = base + (size_t)(row0 + ai * 128 + m * 16) * D + col0;
#pragma unroll
                for (int bj = 0; bj < 2; ++bj) *(u32x4*)(rowp + bj * 128) = pack8(acc[ai][bj][m][0] * s, acc[ai][bj][m][1] * s); }
        if (has_next) ri_reduce(nraw, ri);
    }
};
template <bool FINAL> struct EpiResT { static constexpr bool PERM = true, USES_RI = false; bf16_t* hbf; const bf16_t* lo_in; bf16_t* lo_out; float* out; float* ssq;
    __device__ __forceinline__ void operator()(const pg8::Acc& acc, const Unit& u, bool has_next, const Unit& nxt, float (&ri)[2][4], int wr, int wc, int fr, int fq) const {
        asm volatile("" : "+v"(fr), "+v"(fq));
        const int row0 = u.pm * 256 + wr * 64 + fr, col0 = u.pn * 256 + wc * 32 + 8 * fq;
        u32x4 nb[4];
        { const size_t off = (size_t)row0 * D + col0;
#pragma unroll
          for (int bj = 0; bj < 2; ++bj) { nb[2 * bj] = *(const u32x4*)(hbf + off + bj * 128); nb[2 * bj + 1] = *(const u32x4*)(lo_in + off + bj * 128); } }
#pragma unroll
        for (int g = 0; g < 8; ++g) { const int ai = g >> 2, m = g & 3; const int row = row0 + ai * 128 + m * 16; const size_t off = (size_t)row * D + col0; float ss = 0.f;
            u32x4 cb[4];
#pragma unroll
            for (int k = 0; k < 4; ++k) cb[k] = nb[k];
            if (g < 7) { const size_t noff = (size_t)(row0 + ((g + 1) >> 2) * 128 + ((g + 1) & 3) * 16) * D + col0;
#pragma unroll
                for (int bj = 0; bj < 2; ++bj) { nb[2 * bj] = *(const u32x4*)(hbf + noff + bj * 128); nb[2 * bj + 1] = *(const u32x4*)(lo_in + noff + bj * 128); } }
            asm volatile("" ::: "memory");
#pragma unroll
            for (int bj = 0; bj < 2; ++bj) { const u32x4 hw = cb[2 * bj], lw = cb[2 * bj + 1];
                f32x4 h0, h1;
                h0[0] = (bf_lo(hw.x) + bf_lo(lw.x)) + acc[ai][bj][m][0][0]; h0[1] = (bf_hi(hw.x) + bf_hi(lw.x)) + acc[ai][bj][m][0][1]; h0[2] = (bf_lo(hw.y) + bf_lo(lw.y)) + acc[ai][bj][m][0][2]; h0[3] = (bf_hi(hw.y) + bf_hi(lw.y)) + acc[ai][bj][m][0][3];
                h1[0] = (bf_lo(hw.z) + bf_lo(lw.z)) + acc[ai][bj][m][1][0]; h1[1] = (bf_hi(hw.z) + bf_hi(lw.z)) + acc[ai][bj][m][1][1]; h1[2] = (bf_lo(hw.w) + bf_lo(lw.w)) + acc[ai][bj][m][1][2]; h1[3] = (bf_hi(hw.w) + bf_hi(lw.w)) + acc[ai][bj][m][1][3];
                if (FINAL) { *(f32x4*)(out + off + bj * 128) = h0; *(f32x4*)(out + off + bj * 128 + 4) = h1; }
                else { const u32x4 nh = pack8(h0, h1);
                    f32x4 d0, d1; d0[0] = h0[0] - bf_lo(nh.x); d0[1] = h0[1] - bf_hi(nh.x); d0[2] = h0[2] - bf_lo(nh.y); d0[3] = h0[3] - bf_hi(nh.y); d1[0] = h1[0] - bf_lo(nh.z); d1[1] = h1[1] - bf_hi(nh.z); d1[2] = h1[2] - bf_lo(nh.w); d1[3] = h1[3] - bf_hi(nh.w);
                    *(u32x4*)(hbf + off + bj * 128) = nh; *(u32x4*)(lo_out + off + bj * 128) = pack8(d0, d1); }
                ss += ((h0[0] * h0[0] + h0[1] * h0[1]) + (h0[2] * h0[2] + h0[3] * h0[3])) + ((h1[0] * h1[0] + h1[1] * h1[1]) + (h1[2] * h1[2] + h1[3] * h1[3])); }
            ss += __shfl_xor(ss, 16); ss += __shfl_xor(ss, 32); if (fq == 0) ssq[(size_t)row * 16 + u.pn * 4 + wc] = ss; }
    }
};
struct EpiUp { static constexpr bool PERM = true, USES_RI = true; bf16_t* uo; const float* ssq;
    __device__ __forceinline__ void operator()(const pg8::Acc& acc, const Unit& u, bool has_next, const Unit& nxt, float (&ri)[2][4], int wr, int wc, int fr, int fq) const {
        asm volatile("" : "+v"(fr), "+v"(fq));
        const int row0 = u.pm * 256 + wr * 64 + fr, col0 = u.pn * 256 + wc * 32 + 8 * fq;
        f32x4 nraw[2][4]; if (has_next) ri_issue(ssq, nxt.pm * 256 + wr * 64 + fr, fq, nraw);
#pragma unroll
        for (int ai = 0; ai < 2; ++ai)
#pragma unroll
            for (int m = 0; m < 4; ++m) { const float s = ri[ai][m]; bf16_t* rowp = uo + (size_t)(row0 + ai * 128 + m * 16) * FF + col0;
#pragma unroll
                for (int bj = 0; bj < 2; ++bj) { f32x4 a = acc[ai][bj][m][0] * s, b = acc[ai][bj][m][1] * s;
#pragma unroll
                    for (int e = 0; e < 4; ++e) { const float x = fmaxf(a[e], 0.f), y = fmaxf(b[e], 0.f); a[e] = x * x; b[e] = y * y; }
                    *(u32x4*)(rowp + bj * 128) = pack8(a, b); } }
        if (has_next) ri_reduce(nraw, ri);
    }
};
struct EpiRetQK { static constexpr bool PERM = true, USES_RI = true; bf16_t* SQ; bf16_t* KN; const float* ssq;
    __device__ __forceinline__ void operator()(const pg8::Acc& acc, const Unit& u, bool has_next, const Unit& nxt, float (&ri)[2][4], int wr, int wc, int fr, int fq) const {
        asm volatile("" : "+v"(fr), "+v"(fq));
        const bool isq = u.pn < 4; const int h = u.pn & 3, b = u.pm >> 4, N = u.pm & 15, p = (b * 4 + h) * 16 + N;
        const int row0 = u.pm * 256 + wr * 64 + fr, i0 = wr * 64 + fr, cb = wc * 32 + 8 * fq; const float lg = lg2gamma(h);
        f32x4 nraw[2][4]; if (has_next) ri_issue(ssq, nxt.pm * 256 + wr * 64 + fr, fq, nraw);
        float invf[8];
#pragma unroll
        for (int q = 0; q < 8; ++q) invf[q] = __builtin_amdgcn_exp2f(-(float)(cb + q) * L2B127);
#pragma unroll
        for (int ai = 0; ai < 2; ++ai)
#pragma unroll
            for (int m = 0; m < 4; ++m) { const int il = i0 + ai * 128 + m * 16; const float pos = (float)(N * 256 + il);
                const float s = ri[ai][m], sc = isq ? __builtin_amdgcn_exp2f(lg * (float)(il + 1)) : 0.0625f;
                f32x4 y1[2], y2[2];
#pragma unroll
                for (int n = 0; n < 2; ++n)
#pragma unroll
                    for (int e = 0; e < 4; ++e) { float sn, cs; sincos_rev(pos * invf[n * 4 + e], sn, cs); const float x1 = acc[ai][0][m][n][e] * s, x2 = acc[ai][1][m][n][e] * s;
                        y1[n][e] = (x1 * cs - x2 * sn) * sc; y2[n][e] = (x1 * sn + x2 * cs) * sc; }
                bf16_t* dst = isq ? SQ + (size_t)p * SQ_P + (size_t)il * 512 + 256 + cb : KN + (size_t)(row0 + ai * 128 + m * 16) * 1024 + h * 256 + cb;
                *(u32x4*)dst = pack8(y1[0], y1[1]); *(u32x4*)(dst + 128) = pack8(y2[0], y2[1]);
                if (!isq) {
                    const float kd = __builtin_amdgcn_exp2f(lg * (float)(255 - il)); bf16_t* tb = SQ + (size_t)p * SQ_P + (size_t)cb * 512 + il;
#pragma unroll
                    for (int n = 0; n < 2; ++n)
#pragma unroll
                        for (int e = 0; e < 4; e += 2) { const unsigned w1 = cvt_pk_bf16(y1[n][e] * kd, y1[n][e + 1] * kd), w2 = cvt_pk_bf16(y2[n][e] * kd, y2[n][e + 1] * kd); const int dq = n * 4 + e;
                            tb[(size_t)dq * 512] = (bf16_t)(w1 & 0xffffu); tb[(size_t)(dq + 1) * 512] = (bf16_t)(w1 >> 16);
                            tb[(size_t)(128 + dq) * 512] = (bf16_t)(w2 & 0xffffu); tb[(size_t)(129 + dq) * 512] = (bf16_t)(w2 >> 16); } }
                __builtin_amdgcn_sched_barrier(0); }
        if (has_next) ri_reduce(nraw, ri);
    }
};
struct EpiRetVt { static constexpr bool PERM = true, USES_RI = false; bf16_t* VS; const float* ssq;
    __device__ __forceinline__ void operator()(const pg8::Acc& acc, const Unit& u, bool has_next, const Unit& nxt, float (&ri)[2][4], int wr, int wc, int fr, int fq) const {
        asm volatile("" : "+v"(fr), "+v"(fq));
        const int lane = fq * 16 + fr; const int b = u.pn >> 4, N = u.pn & 15, jb = wc * 32 + 8 * fq;
        float rc[2][8]; rinv_cols(ssq, u.pn * 256 + jb, fr, lane, rc);
        const int h = u.pm >> 1, eh = u.pm & 1, p = (b * 4 + h) * 16 + N;
#pragma unroll
        for (int ai = 0; ai < 2; ++ai)
#pragma unroll
            for (int m = 0; m < 4; ++m) { const int e_row = eh * 256 + ai * 128 + wr * 64 + m * 16 + fr;
#pragma unroll
                for (int bj = 0; bj < 2; ++bj) { f32x4 a = acc[ai][bj][m][0], c = acc[ai][bj][m][1];
#pragma unroll
                    for (int e = 0; e < 4; ++e) { a[e] *= rc[bj][e]; c[e] *= rc[bj][4 + e]; }
                    *(u32x4*)(VS + (size_t)p * VS_P + (size_t)e_row * 512 + bj * 128 + jb) = pack8(a, c); } }
    }
};
struct EpiKV { static constexpr bool PERM = true, USES_RI = false; bf16_t* VS;
    __device__ __forceinline__ void operator()(const pg8::Acc& acc, const Unit& u, bool has_next, const Unit& nxt, float (&ri)[2][4], int wr, int wc, int fr, int fq) const {
        asm volatile("" : "+v"(fr), "+v"(fq));
        bf16_t* base = VS + (size_t)u.p * VS_P + 256 + wc * 32 + 8 * fq;
#pragma unroll
        for (int ai = 0; ai < 2; ++ai)
#pragma unroll
            for (int m = 0; m < 4; ++m) { const int e_row = u.pm * 256 + ai * 128 + wr * 64 + m * 16 + fr;
#pragma unroll
                for (int bj = 0; bj < 2; ++bj) *(u32x4*)(base + (size_t)e_row * 512 + bj * 128) = pack8(acc[ai][bj][m][0], acc[ai][bj][m][1]); }
    }
};
struct EpiS { static constexpr bool PERM = true, USES_RI = false; bf16_t* SQ;
    __device__ __forceinline__ void operator()(const pg8::Acc& acc, const Unit& u, bool has_next, const Unit& nxt, float (&ri)[2][4], int wr, int wc, int fr, int fq) const {
        asm volatile("" : "+v"(fr), "+v"(fq));
        const int h = (u.p >> 4) & 3, jb = wc * 32 + 8 * fq; const float lg = lg2gamma(h);
        float gi[2][8];
#pragma unroll
        for (int bj = 0; bj < 2; ++bj)
#pragma unroll
            for (int q = 0; q < 8; ++q) gi[bj][q] = __builtin_amdgcn_exp2f(-lg * (float)(bj * 128 + jb + q + 1));
#pragma unroll
        for (int ai = 0; ai < 2; ++ai)
#pragma unroll
            for (int m = 0; m < 4; ++m) { const int i = ai * 128 + wr * 64 + m * 16 + fr;
#pragma unroll
                for (int bj = 0; bj < 2; ++bj) { f32x4 a = acc[ai][bj][m][0], c = acc[ai][bj][m][1];
#pragma unroll
                    for (int e = 0; e < 4; ++e) { const int d0 = i - (bj * 128 + jb + e);
                        a[e] = __uint_as_float(__float_as_uint(a[e] * gi[bj][e]) & ~(unsigned)(d0 >> 31)); c[e] = __uint_as_float(__float_as_uint(c[e] * gi[bj][4 + e]) & ~(unsigned)((d0 - 4) >> 31)); }
                    *(u32x4*)(SQ + (size_t)u.p * SQ_P + (size_t)i * 512 + bj * 128 + jb) = pack8(a, c); } __builtin_amdgcn_sched_barrier(0); }
    }
};
struct EpiO { static constexpr bool PERM = true, USES_RI = false; bf16_t* SQ; bf16_t* OH0; float* GN;
    __device__ __forceinline__ void operator()(const pg8::Acc& acc, const Unit& u, bool has_next, const Unit& nxt, float (&ri)[2][4], int wr, int wc, int fr, int fq) const {
        asm volatile("" : "+v"(fr), "+v"(fq));
        const int bh = u.p >> 4, N = u.p & 15, b = bh >> 2, h = bh & 3, cb = wc * 32 + 8 * fq;
        bf16_t* ob = u.pn == 0 ? OH0 + (size_t)u.p * 65536 : SQ + (size_t)u.p * SQ_P; const int pitch = u.pn == 0 ? 256 : 512;
#pragma unroll
        for (int ai = 0; ai < 2; ++ai)
#pragma unroll
            for (int m = 0; m < 4; ++m) { const int i = ai * 128 + wr * 64 + m * 16 + fr; float s = 0.f, q = 0.f;
#pragma unroll
                for (int bj = 0; bj < 2; ++bj) { const f32x4 a = acc[ai][bj][m][0], c = acc[ai][bj][m][1];
                    s += ((a[0] + a[1]) + (a[2] + a[3])) + ((c[0] + c[1]) + (c[2] + c[3]));
                    q += ((a[0] * a[0] + a[1] * a[1]) + (a[2] * a[2] + a[3] * a[3])) + ((c[0] * c[0] + c[1] * c[1]) + (c[2] * c[2] + c[3] * c[3]));
                    *(u32x4*)(ob + (size_t)i * pitch + bj * 128 + cb) = pack8(a, c); }
                s += __shfl_xor(s, 16); s += __shfl_xor(s, 32); q += __shfl_xor(q, 16); q += __shfl_xor(q, 32);
                if (fq == 0) { const size_t tok = (size_t)b * SEQ + N * 256 + i; *(f32x2*)(GN + (tok * 4 + h) * 16 + (u.pn * 4 + wc) * 2) = (f32x2){s, q}; } }
    }
};
struct EpiG { static constexpr bool PERM = true, USES_RI = true; const bf16_t* SQ; const bf16_t* OH0; const float* GN; const float* ssq; bf16_t* Y;
    __device__ __forceinline__ void operator()(const pg8::Acc& acc, const Unit& u, bool has_next, const Unit& nxt, float (&ri)[2][4], int wr, int wc, int fr, int fq) const {
        asm volatile("" : "+v"(fr), "+v"(fq));
        const int b = u.pm >> 4, N = u.pm & 15, h = u.pn >> 1, eh = u.pn & 1, p = (b * 4 + h) * 16 + N, cb = wc * 32 + 8 * fq;
        const int row0 = u.pm * 256 + wr * 64 + fr, i0 = wr * 64 + fr;
        f32x4 nraw[2][4]; if (has_next) ri_issue(ssq, nxt.pm * 256 + wr * 64 + fr, fq, nraw);
        const bf16_t* ob = (eh == 0 ? OH0 + (size_t)p * 65536 : SQ + (size_t)p * SQ_P) + cb; const int pitch = eh == 0 ? 256 : 512;
        const float* gnb = GN + ((size_t)row0 * 4 + h) * 16 + fq * 4;
        u32x4 no[2]; f32x4 nst;
        no[0] = *(const u32x4*)(ob + (size_t)i0 * pitch); no[1] = *(const u32x4*)(ob + (size_t)i0 * pitch + 128); nst = *(const f32x4*)gnb;
#pragma unroll
        for (int g = 0; g < 8; ++g) { const int ai = g >> 2, m = g & 3; const size_t tok = (size_t)row0 + ai * 128 + m * 16;
            const u32x4 co[2] = {no[0], no[1]}; const f32x4 st = nst;
            if (g < 7) { const int r1 = ((g + 1) >> 2) * 128 + ((g + 1) & 3) * 16;
                no[0] = *(const u32x4*)(ob + (size_t)(i0 + r1) * pitch); no[1] = *(const u32x4*)(ob + (size_t)(i0 + r1) * pitch + 128); nst = *(const f32x4*)(gnb + (size_t)r1 * 64); }
            asm volatile("" ::: "memory");
            float s = st[0] + st[2], q = st[1] + st[3];
            s += __shfl_xor(s, 16); s += __shfl_xor(s, 32); q += __shfl_xor(q, 16); q += __shfl_xor(q, 32);
            const float mu = s * (1.0f / RDV), var = fmaxf(q * (1.0f / RDV) - mu * mu, 0.f), rstd = 1.0f / sqrtf(var + GN_EPS), rr = ri[ai][m];
#pragma unroll
            for (int bj = 0; bj < 2; ++bj) { const u32x4 ow = co[bj]; f32x4 a = acc[ai][bj][m][0] * rr, c = acc[ai][bj][m][1] * rr;
                const float o8[8] = {bf_lo(ow.x), bf_hi(ow.x), bf_lo(ow.y), bf_hi(ow.y), bf_lo(ow.z), bf_hi(ow.z), bf_lo(ow.w), bf_hi(ow.w)};
#pragma unroll
                for (int e = 0; e < 4; ++e) { const float g0 = a[e], g1 = c[e];
                    a[e] = g0 * __builtin_amdgcn_rcpf(1.f + __builtin_amdgcn_exp2f(-g0 * LOG2E)) * ((o8[e] - mu) * rstd);
                    c[e] = g1 * __builtin_amdgcn_rcpf(1.f + __builtin_amdgcn_exp2f(-g1 * LOG2E)) * ((o8[4 + e] - mu) * rstd); }
                *(u32x4*)(Y + tok * 2048 + h * 512 + eh * 256 + bj * 128 + cb) = pack8(a, c); } }
        if (has_next) ri_reduce(nraw, ri);
    }
};

struct QKOrder { int G, c; const char* H; const char* W;
    __device__ __forceinline__ bool next(int i, Unit& u) const { const int p = c + (i >> 1) * G; if (p >= NPROB) return false; const int bh = p >> 4, N = p & 15, b = bh >> 2, h = bh & 3; u.p = p; u.pm = b * 16 + N; u.pn = (i & 1) * 4 + h;
        u.a = H + (size_t)u.pm * 256 * D * 2; u.b = W + (size_t)u.pn * 256 * D * 2; return true; } };
struct VtOrder { int G, c; const char* Wv; const char* H;
    __device__ __forceinline__ bool next(int i, Unit& u) const { const int p = c + (i >> 1) * G; if (p >= NPROB) return false; const int bh = p >> 4, N = p & 15, b = bh >> 2, h = bh & 3; u.p = p; u.pm = h * 2 + (i & 1); u.pn = b * 16 + N;
        u.a = Wv + (size_t)u.pm * 256 * D * 2; u.b = H + (size_t)u.pn * 256 * D * 2; return true; } };
struct KVOrder { int G, c; const char* VS; const char* SQ;
    __device__ __forceinline__ bool next(int i, Unit& u) const { const int p = c + (i >> 1) * G; if (p >= NPROB) return false; u.p = p; u.pm = i & 1; u.pn = 0;
        u.a = VS + (size_t)p * VS_P * 2 + (size_t)u.pm * 256 * 512 * 2; u.b = SQ + (size_t)p * SQ_P * 2; return true; } };
struct SOrder { int G, c; const char* SQ; const char* KN;
    __device__ __forceinline__ bool next(int i, Unit& u) const { const int p = c + i * G; if (p >= NPROB) return false; u.p = p; u.pm = 0; u.pn = 0;
        const int bh = p >> 4, N = p & 15, b = bh >> 2, h = bh & 3; u.a = SQ + (size_t)p * SQ_P * 2 + 512; u.b = KN + ((size_t)(b * SEQ + N * 256) * 1024 + h * 256) * 2; return true; } };
struct OOrder { int G, c; const char* SQ; const char* VS;
    __device__ __forceinline__ bool next(int i, Unit& u) const { const int p = c + (i >> 1) * G; if (p >= NPROB) return false; u.p = p; u.pm = 0; u.pn = i & 1;
        u.a = SQ + (size_t)p * SQ_P * 2; u.b = VS + (size_t)p * VS_P * 2 + (size_t)u.pn * 256 * 512 * 2; return true; } };

#define XB_TMO      128
#define XB_XCNT(j)  (256  + 64 * (j))
#define XB_XSUB(j)  (1280 + 64 * (j))
#define XB_XGEN(j)  (2304 + 64 * (j))
#define XB_TOP      3328
#define XB_TOPGEN   3392
#define XCD_BAR_WORDS 3456
#define XB_SPIN_CAP (1u << 18)
__device__ __forceinline__ unsigned xb_ld(unsigned* p)              { return __hip_atomic_load(p, __ATOMIC_RELAXED, __HIP_MEMORY_SCOPE_AGENT); }
__device__ __forceinline__ unsigned xb_add(unsigned* p, unsigned v) { return __hip_atomic_fetch_add(p, v, __ATOMIC_RELAXED, __HIP_MEMORY_SCOPE_AGENT); }
__device__ __forceinline__ unsigned xb_xcc_id() { return (unsigned)__builtin_amdgcn_s_getreg((3 << 11) | 20) & 0xFu; }
#define XB_SPIN(cond, bar) do { unsigned _sp = 0; while (cond) { __builtin_amdgcn_s_sleep(1); \
    if ((++_sp & 255u) == 0u) { if (xb_ld(&(bar)[XB_TMO])) break; if (_sp > XB_SPIN_CAP) { atomicAdd(&(bar)[XB_TMO], 1u); break; } } } } while (0)
struct XcdBarrier { unsigned* bar; unsigned x; volatile LAS unsigned* st; };
__device__ __forceinline__ XcdBarrier xcd_barrier_post(unsigned* bar, volatile LAS unsigned* st) {
    XcdBarrier b; b.bar = bar; b.x = xb_xcc_id(); b.st = st;
    if (threadIdx.x == 0) (void)xb_add(&bar[XB_XCNT(b.x)], 1u);
    return b;
}
__device__ __forceinline__ void xcd_barrier_complete(unsigned* bar, unsigned x, unsigned& nloc, unsigned& nx) {
    const unsigned G = gridDim.x * gridDim.y * gridDim.z;
    unsigned sum, cnt, mine, sp = 0u;
    for (;;) {
        sum = 0u; cnt = 0u; mine = 0u;
#pragma unroll
        for (unsigned j = 0; j < 16; ++j) { const unsigned c = xb_ld(&bar[XB_XCNT(j)]); sum += c; cnt += (c > 0u) ? 1u : 0u; mine = (j == x) ? c : mine; }
        if (sum == G) break;
        __builtin_amdgcn_s_sleep(1);
        if ((++sp & 255u) == 0u) { if (xb_ld(&bar[XB_TMO])) break; if (sp > XB_SPIN_CAP) { atomicAdd(&bar[XB_TMO], 1u); break; } }
    }
    nloc = mine > 0u ? mine : 1u; nx = cnt > 0u ? cnt : 1u;
}
__device__ __forceinline__ void xcd_barrier(const XcdBarrier& b) {
    asm volatile("s_waitcnt vmcnt(0)" ::: "memory");
    __syncthreads();
    if (threadIdx.x == 0) {
        unsigned* bar = b.bar;
        __builtin_amdgcn_s_waitcnt(0);
        unsigned nloc = b.st[0], nx = b.st[1];
        if (nloc == 0u) { xcd_barrier_complete(bar, b.x, nloc, nx); b.st[0] = nloc; b.st[1] = nx; }
        const unsigned old = xb_add(&bar[XB_XSUB(b.x)], 1u);
        const unsigned gen = old / nloc;
        if (old + 1u == (gen + 1u) * nloc) {
            __builtin_amdgcn_fence(__ATOMIC_RELEASE, "agent");
            asm volatile("s_waitcnt vmcnt(0)" ::: "memory");
            const unsigned og = xb_add(&bar[XB_TOP], 1u);
            const unsigned tg = og / nx;
            if (og + 1u == (tg + 1u) * nx) xb_add(&bar[XB_TOPGEN], 1u);
            else XB_SPIN(xb_ld(&bar[XB_TOPGEN]) == tg, bar);
            __builtin_amdgcn_fence(__ATOMIC_ACQUIRE, "agent");
            xb_add(&bar[XB_XGEN(b.x)], 1u);
            asm volatile("s_waitcnt vmcnt(0)" ::: "memory");
        } else {
            XB_SPIN(xb_ld(&bar[XB_XGEN(b.x)]) == gen, bar);
            __builtin_amdgcn_fence(__ATOMIC_ACQUIRE, "agent");
            asm volatile("s_waitcnt vmcnt(0)" ::: "memory");
        }
    }
    __syncthreads();
}

__device__ __forceinline__ void transpose_item(const float* W, const float* g, int K, int N, bf16_t* WT, LAS float* scr, int item, int lane) {
    const int nblk = N / 32, kb = item / nblk, nb = item % nblk, k0 = 64 * kb, n0 = 32 * nb;
    float wv[32];
#pragma unroll
    for (int i = 0; i < 32; ++i) { const int kk = 2 * i + (lane >> 5); wv[i] = W[(size_t)(k0 + kk) * N + n0 + (lane & 31)]; }
    if (g) {
#pragma unroll
        for (int i = 0; i < 32; ++i) wv[i] *= g[k0 + 2 * i + (lane >> 5)]; }
#pragma unroll
    for (int i = 0; i < 32; ++i) scr[(2 * i + (lane >> 5)) * 33 + (lane & 31)] = wv[i];
    LDS_WAIT(); asm volatile("" ::: "memory");
    const int c = lane & 7;
#pragma unroll
    for (int j = 0; j < 4; ++j) { const int n = (lane >> 3) + 8 * j; const LAS float* s = scr + (8 * c) * 33 + n;
        u32x4 o; o.x = cvt_pk_bf16(s[0 * 33], s[1 * 33]); o.y = cvt_pk_bf16(s[2 * 33], s[3 * 33]); o.z = cvt_pk_bf16(s[4 * 33], s[5 * 33]); o.w = cvt_pk_bf16(s[6 * 33], s[7 * 33]);
        *(u32x4*)(WT + (size_t)(n0 + n) * K + k0 + 8 * c) = o; }
    LDS_WAIT(); asm volatile("" ::: "memory");
}
__device__ __forceinline__ void convert_pair(const float* W0, const float* g0, int K0, int N0, bf16_t* T0, const float* W1, const float* g1, int K1, int N1, bf16_t* T1, LAS unsigned char* lds, int gw, int ngw, int wave, int lane) {
    LAS float* scr = (LAS float*)(lds + wave * 16384);
    const int I0 = (K0 / 64) * (N0 / 32), I1 = (K1 / 64) * (N1 / 32);
    for (int it = gw; it < I0 + I1; it += ngw) { if (it < I0) transpose_item(W0, g0, K0, N0, T0, scr, it, lane); else transpose_item(W1, g1, K1, N1, T1, scr, it - I0, lane); }
    __syncthreads();
}
__device__ __forceinline__ void convert_mix(int L, const float* const* in, unsigned char* ws, LAS unsigned char* lds, int gw, int ngw, int wave, int lane) {
    const int i = L >> 1; const float* g = in[5] + (size_t)L * D; bf16_t* T = (bf16_t*)(ws + WS_WMIX);
    if ((L & 1) == 0) convert_pair(in[1] + (size_t)i * D * 3 * D, g, D, 3 * D, T, in[2] + (size_t)i * D * D, nullptr, D, D, T + (size_t)3 * D * D, lds, gw, ngw, wave, lane);
    else convert_pair(in[3] + (size_t)i * D * 6 * D, g, D, 6 * D, T, in[4] + (size_t)i * 2 * D * D, nullptr, 2 * D, D, T + (size_t)6 * D * D, lds, gw, ngw, wave, lane);
}
__device__ __forceinline__ void convert_mlp(int L, const float* const* in, unsigned char* ws, LAS unsigned char* lds, int gw, int ngw, int wave, int lane) {
    bf16_t* T = (bf16_t*)(ws + WS_WMLP);
    convert_pair(in[7] + (size_t)L * D * FF, in[6] + (size_t)L * D, D, FF, T, in[8] + (size_t)L * FF * D, nullptr, FF, D, T + (size_t)FF * D, lds, gw, ngw, wave, lane);
}
__device__ __forceinline__ void p0_rows(const float* x, bf16_t* hbf, bf16_t* lo, float* ssq, int gw, int ngw, int lane) {
    for (int m = gw; m < M / 2; m += ngw) { f32x4 v[2][4]; float s[2];
#pragma unroll
        for (int r = 0; r < 2; ++r) { const f32x4* xr = (const f32x4*)(x + (size_t)(2 * m + r) * D) + lane;
#pragma unroll
            for (int j = 0; j < 4; ++j) v[r][j] = xr[64 * j]; }
#pragma unroll
        for (int r = 0; r < 2; ++r) { s[r] = 0.f;
#pragma unroll
            for (int j = 0; j < 4; ++j) s[r] += (v[r][j][0] * v[r][j][0] + v[r][j][1] * v[r][j][1]) + (v[r][j][2] * v[r][j][2] + v[r][j][3] * v[r][j][3]);
            s[r] = wave_sum(s[r]);
            u32x2* o8 = (u32x2*)(hbf + (size_t)(2 * m + r) * D) + lane; u32x2* l8 = (u32x2*)(lo + (size_t)(2 * m + r) * D) + lane;
#pragma unroll
            for (int j = 0; j < 4; ++j) { u32x2 w; w.x = cvt_pk_bf16(v[r][j][0], v[r][j][1]); w.y = cvt_pk_bf16(v[r][j][2], v[r][j][3]); o8[64 * j] = w;
                u32x2 d; d.x = cvt_pk_bf16(v[r][j][0] - bf_lo(w.x), v[r][j][1] - bf_hi(w.x)); d.y = cvt_pk_bf16(v[r][j][2] - bf_lo(w.y), v[r][j][3] - bf_hi(w.y)); l8[64 * j] = d; }
            if (lane < 16) ssq[(size_t)(2 * m + r) * 16 + lane] = lane == 0 ? s[r] : 0.f; } }
}
__device__ __forceinline__ void final_rows(float* out, const float* ssq, const float* gf, int gw, int ngw, int lane) {
    const f32x4* gr = (const f32x4*)gf + lane; f32x4 gv[4];
#pragma unroll
    for (int j = 0; j < 4; ++j) gv[j] = gr[64 * j];
    for (int m = gw; m < M / 2; m += ngw) { f32x4 v[2][4]; float s[2];
#pragma unroll
        for (int r = 0; r < 2; ++r) { s[r] = ssq[(size_t)(2 * m + r) * 16 + (lane & 15)]; const f32x4* xr = (const f32x4*)(out + (size_t)(2 * m + r) * D) + lane;
#pragma unroll
            for (int j = 0; j < 4; ++j) v[r][j] = xr[64 * j]; }
#pragma unroll
        for (int r = 0; r < 2; ++r) { float t = s[r]; t += __shfl_xor(t, 1); t += __shfl_xor(t, 2); t += __shfl_xor(t, 4); t += __shfl_xor(t, 8);
            const float rr = rinv_of(t); f32x4* xr = (f32x4*)(out + (size_t)(2 * m + r) * D) + lane;
#pragma unroll
            for (int j = 0; j < 4; ++j) xr[64 * j] = v[r][j] * rr * gv[j]; } }
}
__device__ __forceinline__ void ret_scan(bf16_t* VS, int gtid, int gthreads) {
    for (int g = gtid; g < BATCH * RH * RDV * 32; g += gthreads) { const int bh = g >> 14, rem = g & 16383, e = rem >> 5, dg = rem & 31, h = bh & 3;
        const float dec = __builtin_amdgcn_exp2f(256.f * lg2gamma(h));
        bf16_t* p = VS + (size_t)bh * 16 * VS_P + (size_t)e * 512 + 256 + dg * 8; float st[8];
#pragma unroll
        for (int k = 0; k < 8; ++k) st[k] = 0.f;
        u32x4 w[16];
#pragma unroll
        for (int N = 0; N < 16; ++N) w[N] = *(const u32x4*)(p + (size_t)N * VS_P);
#pragma unroll
        for (int N = 0; N < 16; ++N) { u32x4 o; o.x = cvt_pk_bf16(st[0], st[1]); o.y = cvt_pk_bf16(st[2], st[3]); o.z = cvt_pk_bf16(st[4], st[5]); o.w = cvt_pk_bf16(st[6], st[7]);
            *(u32x4*)(p + (size_t)N * VS_P) = o;
            st[0] = dec * st[0] + bf_lo(w[N].x); st[1] = dec * st[1] + bf_hi(w[N].x); st[2] = dec * st[2] + bf_lo(w[N].y); st[3] = dec * st[3] + bf_hi(w[N].y);
            st[4] = dec * st[4] + bf_lo(w[N].z); st[5] = dec * st[5] + bf_hi(w[N].z); st[6] = dec * st[6] + bf_lo(w[N].w); st[7] = dec * st[7] + bf_hi(w[N].w); } }
}
__device__ __forceinline__ void sb_attn_simple(const bf16_t* Q, const bf16_t* K, const bf16_t* V, bf16_t* O, int gw, int ngw, int lane) {
    for (int task = gw; task < BATCH * SBH * (SEQ / 64); task += ngw) {
        const int bh = task >> 6, qb = task & 63, b = bh >> 4, h = bh & 15, q0 = qb * 64, t = q0 + lane;
        const size_t rowoff = ((size_t)b * SEQ + t) * D + h * SBD;
        float q[64], o[64];
#pragma unroll
        for (int i = 0; i < 8; ++i) { const u32x4 w = *(const u32x4*)(Q + rowoff + i * 8); q[8 * i + 0] = bf_lo(w.x); q[8 * i + 1] = bf_hi(w.x); q[8 * i + 2] = bf_lo(w.y); q[8 * i + 3] = bf_hi(w.y);
            q[8 * i + 4] = bf_lo(w.z); q[8 * i + 5] = bf_hi(w.z); q[8 * i + 6] = bf_lo(w.w); q[8 * i + 7] = bf_hi(w.w); }
#pragma unroll
        for (int i = 0; i < 64; ++i) o[i] = 0.f;
        float carry = 0.f;
        const bf16_t* Kb = K + (size_t)b * SEQ * D + h * SBD; const bf16_t* Vb = V + (size_t)b * SEQ * D + h * SBD;
        for (int s = q0 + 62; s >= 0; --s) {
            const u32x4* kr = (const u32x4*)(Kb + (size_t)s * D); float z0 = 0.f, z1 = 0.f;
#pragma unroll
            for (int i = 0; i < 8; ++i) { const u32x4 w = kr[i];
                z0 += q[8 * i + 0] * bf_lo(w.x); z1 += q[8 * i + 1] * bf_hi(w.x); z0 += q[8 * i + 2] * bf_lo(w.y); z1 += q[8 * i + 3] * bf_hi(w.y);
                z0 += q[8 * i + 4] * bf_lo(w.z); z1 += q[8 * i + 5] * bf_hi(w.z); z0 += q[8 * i + 6] * bf_lo(w.w); z1 += q[8 * i + 7] * bf_hi(w.w); }
            const float z = z0 + z1;
            const float l = __builtin_amdgcn_logf(1.f + __builtin_amdgcn_exp2f(-fabsf(z)));
            const float lk = -(fmaxf(z, 0.f) + l);
            const bool valid = s < t;
            const float a = valid ? __builtin_amdgcn_exp2f((z + lk) + carry) : 0.f;
            carry += valid ? lk : 0.f;
            const u32x4* vr = (const u32x4*)(Vb + (size_t)s * D);
#pragma unroll
            for (int i = 0; i < 8; ++i) { const u32x4 w = vr[i];
                o[8 * i + 0] += a * bf_lo(w.x); o[8 * i + 1] += a * bf_hi(w.x); o[8 * i + 2] += a * bf_lo(w.y); o[8 * i + 3] += a * bf_hi(w.y);
                o[8 * i + 4] += a * bf_lo(w.z); o[8 * i + 5] += a * bf_hi(w.z); o[8 * i + 6] += a * bf_lo(w.w); o[8 * i + 7] += a * bf_hi(w.w); }
            if (__all(carry < -152.f)) break;
        }
#pragma unroll
        for (int i = 0; i < 8; ++i) { u32x4 w; w.x = cvt_pk_bf16(o[8 * i + 0], o[8 * i + 1]); w.y = cvt_pk_bf16(o[8 * i + 2], o[8 * i + 3]); w.z = cvt_pk_bf16(o[8 * i + 4], o[8 * i + 5]); w.w = cvt_pk_bf16(o[8 * i + 6], o[8 * i + 7]);
            *(u32x4*)(O + rowoff + i * 8) = w; }
    }
}


typedef float f32x16 __attribute__((ext_vector_type(16)));
typedef short v4i16_t __attribute__((ext_vector_type(4)));
__device__ __forceinline__ v4i16_t vtr(const LAS unsigned char* p) { return __builtin_amdgcn_ds_read_tr16_b64_v4i16((LAS v4i16_t*)p); }
__device__ __forceinline__ float lane_partner(float mine) {
    const unsigned m = __float_as_uint(mine); const auto rr = __builtin_amdgcn_permlane32_swap(m, m, false, false); return __uint_as_float(rr[0] ^ rr[1] ^ m);
}
template <bool DIAG> __device__ __forceinline__ void sb_tile_math(float (&zz)[32], float& carry, int qlim, int hi, float m0) {
    float lk[32];
#pragma unroll
    for (int n = 0; n < 32; ++n) { const float z = zz[n];
        const float l = __builtin_amdgcn_logf(1.f + __builtin_amdgcn_exp2f(-fabsf(z)));
        const float zp = __builtin_amdgcn_fmed3f(z, 0.f, INFINITY);
        float k = -(zp + l), s = z + k;
        if (DIAG) { const bool v = ((n & 3) + 8 * ((n & 15) >> 2) + 32 * (n >> 4)) < qlim; k = v ? k : 0.f; s = v ? s : -INFINITY; }
        lk[n] = k; zz[n] = s; }
    float W = 0.f, off[8];
#pragma unroll
    for (int i = 7; i >= 0; --i) { const float t = ((lk[4 * i + 3] + lk[4 * i + 2]) + lk[4 * i + 1]) + lk[4 * i]; const float other = lane_partner(t); off[i] = carry + (W + m0 * other); W += t + other; }
    carry += W;
#pragma unroll
    for (int i = 0; i < 8; ++i) { const float bs = off[i], a = lk[4 * i + 3], b = a + lk[4 * i + 2], c = b + lk[4 * i + 1];
        zz[4 * i + 3] = __builtin_amdgcn_exp2f(zz[4 * i + 3] + bs); zz[4 * i + 2] = __builtin_amdgcn_exp2f(zz[4 * i + 2] + (bs + a));
        zz[4 * i + 1] = __builtin_amdgcn_exp2f(zz[4 * i + 1] + (bs + b)); zz[4 * i] = __builtin_amdgcn_exp2f(zz[4 * i] + (bs + c)); }
}
__device__ __forceinline__ void sb_load_tile(bf16x8 (&kf)[8], u32x4 (&vv)[8], const bf16_t* Kh, const bf16_t* Vh, int j, int lane) {
    const int r32 = lane & 31, hi = lane >> 5;
    const bf16_t* kp = Kh + (size_t)(64 * j + r32) * D + 8 * hi;
#pragma unroll
    for (int d0 = 0; d0 < 4; ++d0) { kf[2 * d0] = *(const bf16x8*)(kp + 16 * d0); kf[2 * d0 + 1] = *(const bf16x8*)(kp + (size_t)32 * D + 16 * d0); }
    const bf16_t* vp = Vh + (size_t)(64 * j + (lane >> 2)) * D + (lane & 3) * 8;
#pragma unroll
    for (int w = 0; w < 8; ++w) vv[w] = *(const u32x4*)(vp + (size_t)(16 * (w & 3)) * D + (w >> 2) * 32);
}
template <bool DIAG> __device__ __forceinline__ void sb_tile(const bf16x8 (&kf)[8], const bf16x8 (&qr)[4], const LAS unsigned char* vp0, f32x16& o0, f32x16& o1, float& carry, int qlim, int hi, float m0) {
    f32x16 p0 = {0.f, 0.f, 0.f, 0.f, 0.f, 0.f, 0.f, 0.f, 0.f, 0.f, 0.f, 0.f, 0.f, 0.f, 0.f, 0.f}, p1 = p0;
#pragma unroll
    for (int d0 = 0; d0 < 4; ++d0) { p0 = __builtin_amdgcn_mfma_f32_32x32x16_bf16(kf[2 * d0], qr[d0], p0, 0, 0, 0); p1 = __builtin_amdgcn_mfma_f32_32x32x16_bf16(kf[2 * d0 + 1], qr[d0], p1, 0, 0, 0); }
    float zz[32];
#pragma unroll
    for (int r = 0; r < 16; ++r) { zz[r] = p0[r]; zz[16 + r] = p1[r]; }
    sb_tile_math<DIAG>(zz, carry, qlim, hi, m0);
    u32x4 pw[4];
#pragma unroll
    for (int k = 0; k < 4; ++k) { pw[k].x = cvt_pk_bf16(zz[8 * k + 0], zz[8 * k + 1]); pw[k].y = cvt_pk_bf16(zz[8 * k + 2], zz[8 * k + 3]); pw[k].z = cvt_pk_bf16(zz[8 * k + 4], zz[8 * k + 5]); pw[k].w = cvt_pk_bf16(zz[8 * k + 6], zz[8 * k + 7]); }
#pragma unroll
    for (int d0 = 0; d0 < 2; ++d0)
#pragma unroll
        for (int ks = 0; ks < 4; ++ks) { const v4i16_t lo = vtr(vp0 + d0 * 4096 + ks * 1024), hh = vtr(vp0 + d0 * 4096 + ks * 1024 + 512);
            const bf16x8 vf = (bf16x8){lo[0], lo[1], lo[2], lo[3], hh[0], hh[1], hh[2], hh[3]};
            if (d0 == 0) o0 = __builtin_amdgcn_mfma_f32_32x32x16_bf16(__builtin_bit_cast(bf16x8, pw[ks]), vf, o0, 0, 0, 0);
            else o1 = __builtin_amdgcn_mfma_f32_32x32x16_bf16(__builtin_bit_cast(bf16x8, pw[ks]), vf, o1, 0, 0, 0); }
}
__device__ __forceinline__ void sb_attn_mfma(const bf16_t* Q, const bf16_t* K, const bf16_t* V, bf16_t* O, unsigned* qctr, LAS unsigned char* lds, int gw, int ngw, int wave, int lane_in) {
    LAS unsigned char* vb = lds + wave * 8192;
    const int xq = (gw >> 3) & 7;
    unsigned nextu = 0u; if ((lane_in & 63) == 0) nextu = __hip_atomic_fetch_add(qctr + xq * 64, 1u, __ATOMIC_RELAXED, __HIP_MEMORY_SCOPE_AGENT);
    for (;;) {
        const int lu = __builtin_amdgcn_readfirstlane((int)nextu); if (lu >= 8 * 128) break;
        if ((lane_in & 63) == 0) nextu = __hip_atomic_fetch_add(qctr + xq * 64, 1u, __ATOMIC_RELAXED, __HIP_MEMORY_SCOPE_AGENT);
        const int unit = ((xq + 8 * (lu >> 7)) << 7) | (127 - (lu & 127));
        int lane = lane_in; asm volatile("" : "+v"(lane));
        const int r32 = lane & 31, hi = lane >> 5; const float m0 = hi == 0 ? 1.f : 0.f;
        const LAS unsigned char* vp0 = vb + ((lane >> 4) & 1) * 32 + (lane & 3) * 8 + (4 * hi + ((lane & 15) >> 2)) * 64;
        LAS unsigned char* vw = vb + lane * 16;
        const int bh = unit >> 7, qb = unit & 127, b = bh >> 4, h = bh & 15, qs = qb * 32, jd = qs >> 6;
        const bf16_t* Qw = Q + ((size_t)b * SEQ + qs + r32) * D + h * SBD + hi * 8;
        bf16x8 qr[4];
#pragma unroll
        for (int d0 = 0; d0 < 4; ++d0) qr[d0] = *(const bf16x8*)(Qw + d0 * 16);
        const bf16_t* Kh = K + (size_t)b * SEQ * D + h * SBD; const bf16_t* Vh = V + (size_t)b * SEQ * D + h * SBD;
        bf16x8 kc[8], kn[8]; u32x4 vn[8];
        int j = jd;
        sb_load_tile(kc, vn, Kh, Vh, j, lane);
#pragma unroll
        for (int w = 0; w < 8; ++w) *(LAS u32x4*)(vw + w * 1024) = vn[w];
        f32x16 o0 = {0.f, 0.f, 0.f, 0.f, 0.f, 0.f, 0.f, 0.f, 0.f, 0.f, 0.f, 0.f, 0.f, 0.f, 0.f, 0.f}, o1 = o0; float carry = 0.f;
        if (j > 0) sb_load_tile(kn, vn, Kh, Vh, j - 1, lane);
        sb_tile<true>(kc, qr, vp0, o0, o1, carry, (qs & 63) + r32 - 4 * hi, hi, m0);
        while (j > 0 && !__all(carry < -152.f)) {
#pragma unroll
            for (int w = 0; w < 8; ++w) *(LAS u32x4*)(vw + w * 1024) = vn[w];
#pragma unroll
            for (int i = 0; i < 8; ++i) kc[i] = kn[i];
            --j;
            if (j > 0) sb_load_tile(kn, vn, Kh, Vh, j - 1, lane);
            sb_tile<false>(kc, qr, vp0, o0, o1, carry, 0, hi, m0);
        }
        bf16_t* Ow = O + ((size_t)b * SEQ + qs + 4 * hi) * D + h * SBD + r32;
#pragma unroll
        for (int r = 0; r < 16; ++r) { const int q = (r & 3) + 8 * (r >> 2); const unsigned w0 = cvt_pk_bf16(o0[r], o1[r]);
            Ow[(size_t)q * D] = (bf16_t)(w0 & 0xffffu); Ow[(size_t)q * D + 32] = (bf16_t)(w0 >> 16); }
    }
}

#ifndef PROBE_SEL
#define PROBE_SEL -1
#endif
#ifndef PROBE_BLOCK
#define PROBE_BLOCK 0
#endif
struct Probe { unsigned long long last, sel, tb, bw; };
#if PROBE_SEL >= 0
#define PH_END(k) do { const unsigned long long now_ = __builtin_amdgcn_s_memrealtime(); if ((k) == PROBE_SEL) pr.sel += now_ - pr.last; if ((k) + 100 == PROBE_SEL) pr.sel += pr.bw; pr.last = now_; } while (0)
#define GRID_BAR() do { pr.tb = __builtin_amdgcn_s_memrealtime(); xcd_barrier(bar); pr.bw = __builtin_amdgcn_s_memrealtime() - pr.tb; if (PROBE_SEL == 13) pr.sel += pr.bw; } while (0)
#else
#define PH_END(k) do { } while (0)
#define GRID_BAR() xcd_barrier(bar)
#endif
struct Args { const float* in[10]; float* out; unsigned char* ws; };
struct Ctx { LAS unsigned char* lds; unsigned char* ws; const float* const* in; float* out; int G, bx, gw, ngw, wave, lane, tid; };

template <int L> __device__ __forceinline__ void layer(const Ctx& c, const XcdBarrier& bar, Probe& pr) {
    LAS unsigned char* lds = c.lds; unsigned char* ws = c.ws; const int G = c.G, bx = c.bx;
    const float* x = c.in[0]; float* out = c.out;
    float* ssq = (float*)(ws + WS_SSQ); float* GN = (float*)(ws + WS_GN);
    bf16_t* hbf = (bf16_t*)(ws + WS_HBF); bf16_t* wmix = (bf16_t*)(ws + WS_WMIX); bf16_t* wmlp = (bf16_t*)(ws + WS_WMLP);
    bf16_t* lo = (bf16_t*)out;
    bf16_t* lo_alt = (bf16_t*)(ws + WS_LOALT);
    if constexpr ((L & 1) == 0) {
        bf16_t* Qb = (bf16_t*)(ws + WS_Q); bf16_t* Kb = (bf16_t*)(ws + WS_K); bf16_t* Vb = (bf16_t*)(ws + WS_V);
        { pg8::StdOrder S; S.init(M, 3 * D, G, bx, hbf, wmix, D, D); EpiQKV E{Qb, ssq};
          pg8::gemm_phase<EpiQKV, pg8::StdOrder, D, D, D, true>(lds, S, E); }
        GRID_BAR(); PH_END(1);
        sb_attn_mfma(Qb, Kb, Vb, Qb, (unsigned*)(ws + WS_CTL) + 8192 + (L >> 1) * 512, lds, c.gw, c.ngw, c.wave, c.lane);
        GRID_BAR(); PH_END(2);
        convert_mlp(L, c.in, ws, lds, c.gw, c.ngw, c.wave, c.lane);
        { pg8::StdOrder S; S.init(M, D, G, bx, Qb, wmix + (size_t)3 * D * D, D, D); EpiResT<false> E{hbf, lo, lo, out, ssq};
          pg8::gemm_phase<EpiResT<false>, pg8::StdOrder, D, D, D, false>(lds, S, E); }
        GRID_BAR(); PH_END(3);
    } else {
        bf16_t* SQ = (bf16_t*)(ws + WS_SQ); bf16_t* VS = (bf16_t*)(ws + WS_VS); bf16_t* KN = (bf16_t*)(ws + WS_KN); bf16_t* Y = (bf16_t*)(ws + WS_Y);
        { QKOrder S{G, bx, (const char*)hbf, (const char*)wmix}; EpiRetQK E{SQ, KN, ssq};
          pg8::gemm_phase<EpiRetQK, QKOrder, D, D, D, true>(lds, S, E); }
        { VtOrder S{G, bx, (const char*)(wmix + (size_t)2 * D * D), (const char*)hbf}; EpiRetVt E{VS, ssq};
          pg8::gemm_phase<EpiRetVt, VtOrder, D, D, D, true>(lds, S, E); }
        PH_END(4);
        { KVOrder S{G, bx, (const char*)VS, (const char*)SQ}; EpiKV E{VS};
          pg8::gemm_phase<EpiKV, KVOrder, 512, 512, 256, true>(lds, S, E); }
        { SOrder S{G, bx, (const char*)SQ, (const char*)KN}; EpiS E{SQ};
          pg8::gemm_phase<EpiS, SOrder, 512, 1024, 256, true>(lds, S, E); }
        GRID_BAR(); PH_END(5);
        ret_scan(VS, bx * NWAVES * 64 + c.tid, G * NWAVES * 64);
        GRID_BAR(); PH_END(6);
        { OOrder S{G, bx, (const char*)SQ, (const char*)VS}; EpiO E{SQ, KN, GN};
          pg8::gemm_phase<EpiO, OOrder, 512, 512, 512, true>(lds, S, E); }
        GRID_BAR(); PH_END(7);
        { pg8::StdOrder S; S.init(M, 2 * D, G, bx, hbf, wmix + (size_t)4 * D * D, D, D); EpiG E{SQ, KN, GN, ssq, Y};
          pg8::gemm_phase<EpiG, pg8::StdOrder, D, D, D, true>(lds, S, E); }
        GRID_BAR(); PH_END(8);
        convert_mlp(L, c.in, ws, lds, c.gw, c.ngw, c.wave, c.lane);
        { pg8::StdOrder S; S.init(M, D, G, bx, Y, wmix + (size_t)6 * D * D, 2 * D, 2 * D); EpiResT<false> E{hbf, lo, (L == NLAYER - 1) ? lo_alt : lo, out, ssq};
          pg8::gemm_phase<EpiResT<false>, pg8::StdOrder, 2 * D, 2 * D, 2 * D, false>(lds, S, E); }
        GRID_BAR(); PH_END(9);
    }
    bf16_t* U = (bf16_t*)(ws + WS_U);
    { pg8::StdOrder S; S.init(M, FF, G, bx, hbf, wmlp, D, D); EpiUp E{U, ssq};
      pg8::gemm_phase<EpiUp, pg8::StdOrder, D, D, D, true>(lds, S, E); }
    GRID_BAR(); PH_END(10);
    if constexpr (L + 1 < NLAYER) convert_mix(L + 1, c.in, ws, lds, c.gw, c.ngw, c.wave, c.lane);
    if constexpr (L == NLAYER - 1) { pg8::StdOrder S; S.init(M, D, G, bx, U, wmlp + (size_t)FF * D, FF, FF); EpiResT<true> E{hbf, lo_alt, lo_alt, out, ssq};
      pg8::gemm_phase<EpiResT<true>, pg8::StdOrder, FF, FF, FF, false>(lds, S, E); }
    else { pg8::StdOrder S; S.init(M, D, G, bx, U, wmlp + (size_t)FF * D, FF, FF); EpiResT<false> E{hbf, lo, lo, out, ssq};
      pg8::gemm_phase<EpiResT<false>, pg8::StdOrder, FF, FF, FF, false>(lds, S, E); }
    GRID_BAR(); PH_END(11);
}

__global__ void __launch_bounds__(NWAVES * 64, 2) trunk_fwd(Args args) {
    extern __shared__ __attribute__((aligned(16))) unsigned char lds_raw[];
    LAS unsigned char* lds = (LAS unsigned char*)lds_raw;
    volatile LAS unsigned* MISC = (volatile LAS unsigned*)(lds + MISC_OFF);
    const int tid = threadIdx.x, lane = tid & 63, wave = __builtin_amdgcn_readfirstlane(tid >> 6);
    const int G = gridDim.x, bx = blockIdx.x;
    const int gw = bx * NWAVES + wave, ngw = G * NWAVES;
    unsigned char* ws = args.ws;
    unsigned* ctl = (unsigned*)(ws + WS_CTL);
    for (int u = tid; u < (LDS_BYTES - LDSCTL_OFF) / 4; u += NWAVES * 64) ((LAS unsigned*)(lds + LDSCTL_OFF))[u] = 0u;
    __syncthreads();
    const XcdBarrier bar = xcd_barrier_post(ctl + 4096, MISC + 8);
    const Ctx c{lds, ws, args.in, args.out, G, bx, gw, ngw, wave, lane, tid};
    Probe pr{0ull, 0ull, 0ull, 0ull};
#if PROBE_SEL >= 0
    pr.last = __builtin_amdgcn_s_memrealtime();
#endif

    p0_rows(args.in[0], (bf16_t*)(ws + WS_HBF), (bf16_t*)args.out, (float*)(ws + WS_SSQ), gw, ngw, lane);
    convert_mix(0, args.in, ws, lds, gw, ngw, wave, lane);
    GRID_BAR(); PH_END(0);
    layer<0>(c, bar, pr); layer<1>(c, bar, pr); layer<2>(c, bar, pr); layer<3>(c, bar, pr);
    { int lane_f = lane; asm volatile("" : "+v"(lane_f));
      final_rows(args.out, (const float*)(ws + WS_SSQ), args.in[9], gw, ngw, lane_f); }
#if PROBE_SEL >= 0
    PH_END(12);
    if (bx == PROBE_BLOCK && tid == 0) { const unsigned long long t0 = __builtin_amdgcn_s_memrealtime(); while (__builtin_amdgcn_s_memrealtime() - t0 < 8ull * pr.sel) __builtin_amdgcn_s_sleep(8); }
#endif
}

extern "C" void kernel_launch(void* const* d_in, const int* in_sizes, int n_in, void* d_out, int out_size, void* d_ws, size_t ws_size, hipStream_t stream) {
    static int grid = 0;
    if (grid == 0) {
        if (n_in != 10 || in_sizes[0] != M * D || out_size != M * D || ws_size < WS_END) { fprintf(stderr, "kernel_launch: unexpected shapes / workspace (%d inputs, ws %zu < %zu)\n", n_in, ws_size, (size_t)WS_END); grid = -1; return; }
        int dev = 0, cus = 0, per_cu = 0;
        if (hipGetDevice(&dev) != hipSuccess || hipDeviceGetAttribute(&cus, hipDeviceAttributeMultiprocessorCount, dev) != hipSuccess) { grid = -1; return; }
        if (hipFuncSetAttribute((const void*)trunk_fwd, hipFuncAttributeMaxDynamicSharedMemorySize, LDS_BYTES) != hipSuccess) { fprintf(stderr, "kernel_launch: hipFuncSetAttribute failed\n"); grid = -1; return; }
        if (hipOccupancyMaxActiveBlocksPerMultiprocessor(&per_cu, (const void*)trunk_fwd, NWAVES * 64, LDS_BYTES) != hipSuccess || per_cu < 1) fprintf(stderr, "kernel_launch: occupancy query reports %d\n", per_cu);
        (void)hipGetLastError();
        grid = cus;
    }
    if (grid < 0) return;
    if (hipMemsetAsync((char*)d_ws + WS_CTL, 0, CTL_ZERO_BYTES, stream) != hipSuccess) return;
    Args a{};
    for (int i = 0; i < 10; ++i) a.in[i] = (const float*)d_in[i];
    a.out = (float*)d_out; a.ws = (unsigned char*)d_ws;
    hipLaunchKernelGGL(trunk_fwd, dim3(grid), dim3(NWAVES * 64), LDS_BYTES, stream, a);
}
```
